# Optimizing an MI355X kernel written in HIP

```python
import math
import jax
import jax.numpy as jnp
from jax import lax
import numpy as np

D_MODEL = 2048
BATCH = 4
SEQ = 2048
DEPTH = 2


CTX_LEN = 256
GRID_W = 64
HEAD_DIM = 128
MIX_WIDTH = D_MODEL
S5_WIDTH = MIX_WIDTH // 4
S5_GROUP = 16
S5_GROUPS = S5_WIDTH // S5_GROUP
S5_STATE = 64
RET_WIDTH = 3 * MIX_WIDTH // 8
RET_HEADS = RET_WIDTH // HEAD_DIM
MLSTM_WIDTH = MIX_WIDTH - S5_WIDTH - RET_WIDTH
MLSTM_HEADS = MLSTM_WIDTH // HEAD_DIM
IN_WIDTH = S5_WIDTH + 4 * RET_WIDTH + 4 * MLSTM_WIDTH + 4 * MLSTM_HEADS
IN_SPLITS = (S5_WIDTH, S5_WIDTH + 4 * RET_WIDTH, S5_WIDTH + 4 * RET_WIDTH + 4 * MLSTM_WIDTH)
D_FF = 4 * D_MODEL
CHUNK = 128
ROPE_BASE = 10000.0
EPS = 1e-6
S5_DT_MIN = 0.001
S5_DT_MAX = 0.1

kernel_name = 'hybrid_s5_retention_mlstm_dit_block'

F32 = jnp.float32


def _rmsnorm(x, w):
    xf = x.astype(F32)
    y = xf * lax.rsqrt(jnp.mean(xf * xf, axis=-1, keepdims=True) + EPS)
    return (y * w.astype(F32)).astype(x.dtype)


def _modulate(h, shift, scale):
    return h * (1.0 + scale) + shift


def _heads(t, n_heads):
    b, l, _ = t.shape
    return t.reshape(b, l, n_heads, -1).transpose(0, 2, 1, 3).astype(F32)


def _flip(t, rev, axis):
    return jnp.flip(t, axis=axis) if rev else t


def _chunks(t):
    b, hh, l = t.shape[:3]
    return jnp.moveaxis(t.reshape((b, hh, l // CHUNK, CHUNK) + t.shape[3:]), 2, 0)


def _unchunk(t):
    t = jnp.moveaxis(t, 0, 2)
    return t.reshape(t.shape[:2] + (t.shape[2] * t.shape[3],) + t.shape[4:])


def _rope_2d_tables(rows, cols):
    quarter = HEAD_DIM // 4
    inv = ROPE_BASE ** (-jnp.arange(quarter, dtype=F32) / quarter)
    ang = jnp.concatenate([rows[:, None] * inv, cols[:, None] * inv], axis=-1)
    return jnp.cos(ang), jnp.sin(ang)


def _apply_rope(t, cos, sin):
    half = t.shape[-1] // 2
    t1, t2 = t[..., :half], t[..., half:]
    return jnp.concatenate([t1 * cos - t2 * sin, t1 * sin + t2 * cos], axis=-1)


def _head_norm(o, w, center):
    if center:
        o = o - jnp.mean(o, axis=-1, keepdims=True)
    o = o * lax.rsqrt(jnp.mean(o * o, axis=-1, keepdims=True) + EPS)
    b, hh, l, dh = o.shape
    return o.transpose(0, 2, 1, 3).reshape(b, l, hh * dh) * w.astype(F32)


def _cmul(ar, ai, br, bi):
    return ar * br - ai * bi, ar * bi + ai * br


def _s5_discretise(lam_re, lam_im, log_step, b_re, b_im):
    lam_re = jnp.minimum(lam_re.astype(F32), -1e-4)
    lam_im = lam_im.astype(F32)
    step = jnp.exp(log_step.astype(F32))[:, None]
    mag = jnp.exp(lam_re * step)
    ab_re, ab_im = mag * jnp.cos(lam_im * step), mag * jnp.sin(lam_im * step)
    den = lam_re * lam_re + lam_im * lam_im
    nr, ni = _cmul(ab_re - 1.0, ab_im, lam_re / den, -lam_im / den)
    bb_re, bb_im = _cmul(nr[..., None], ni[..., None], b_re.astype(F32), b_im.astype(F32))
    return ab_re, ab_im, bb_re, bb_im


def _s5_scan(u, ab_re, ab_im, bb_re, bb_im, x0_re, x0_im):
    bu_re = jnp.einsum('gpn,blgn->blgp', bb_re, u)
    bu_im = jnp.einsum('gpn,blgn->blgp', bb_im, u)
    ir, ii = _cmul(ab_re, ab_im, x0_re, x0_im)
    bu_re = bu_re.at[:, 0].add(ir)
    bu_im = bu_im.at[:, 0].add(ii)
    a_re = jnp.broadcast_to(ab_re, bu_re.shape)
    a_im = jnp.broadcast_to(ab_im, bu_im.shape)

    def combine(e1, e2):
        a1r, a1i, b1r, b1i = e1
        a2r, a2i, b2r, b2i = e2
        ar, ai = _cmul(a2r, a2i, a1r, a1i)
        br, bi = _cmul(a2r, a2i, b1r, b1i)
        return ar, ai, br + b2r, bi + b2i

    _, _, xr, xi = lax.associative_scan(combine, (a_re, a_im, bu_re, bu_im), axis=1)
    return xr, xi


def _s5_readout(c_re, c_im, xr, xi):
    return jnp.einsum('gnp,blgp->blgn', c_re.astype(F32), xr) - jnp.einsum('gnp,blgp->blgn', c_im.astype(F32), xi)


def _s5_mixer(u_x, u_h, lam_re, lam_im, log_step, b_re, b_im, c_re, c_im, d_skip):
    def groups(u):
        b, l, _ = u.shape
        return u.astype(F32).reshape(b, l, S5_GROUPS, S5_GROUP)

    ux, uh = groups(u_x), groups(u_h)
    dsk = d_skip.astype(F32).reshape(S5_GROUPS, S5_GROUP)
    yx, yh = dsk * ux, dsk * uh
    zero = jnp.zeros((ux.shape[0], S5_GROUPS, S5_STATE), F32)
    for d in range(2):
        rev = d == 1
        ab_re, ab_im, bb_re, bb_im = _s5_discretise(lam_re[d], lam_im[d], log_step[d], b_re[d], b_im[d])
        sr, si = _s5_scan(_flip(uh, rev, 1), ab_re, ab_im, bb_re, bb_im, zero, zero)
        yh = yh + _flip(_s5_readout(c_re[d], c_im[d], sr, si), rev, 1)
        sr, si = _s5_scan(_flip(ux, rev, 1), ab_re, ab_im, bb_re, bb_im, sr[:, -1], si[:, -1])
        yx = yx + _flip(_s5_readout(c_re[d], c_im[d], sr, si), rev, 1)
    return yx, yh


def _s5_glu(y, w_glu, b_glu):
    b, l = y.shape[:2]
    z = jax.nn.gelu(y.reshape(b, l, S5_WIDTH)) @ w_glu.astype(F32) + b_glu.astype(F32)
    return z[..., :S5_WIDTH] * jax.nn.sigmoid(z[..., S5_WIDTH:])


def _retention_dir(q, k, v, log_gamma, r0):
    idx = jnp.arange(CHUNK, dtype=F32)
    rel = idx[:, None] - idx[None, :]
    lg = log_gamma[:, None, None]
    decay = jnp.where(rel >= 0, jnp.exp(lg * jnp.maximum(rel, 0.0)), 0.0)
    q_decay = jnp.exp(log_gamma[:, None] * (idx + 1.0))[..., None]
    k_decay = jnp.exp(log_gamma[:, None] * (CHUNK - 1.0 - idx))[..., None]
    chunk_decay = jnp.exp(log_gamma * CHUNK)[:, None, None]

    def step(r, inp):
        qi, ki, vi = inp
        s = jnp.einsum('bhid,bhjd->bhij', qi, ki) * decay
        o = jnp.einsum('bhij,bhjv->bhiv', s, vi) + jnp.einsum('bhid,bhdv->bhiv', qi * q_decay, r)
        r = chunk_decay * r + jnp.einsum('bhjd,bhjv->bhdv', ki * k_decay, vi)
        return r, o

    r, o = lax.scan(step, r0, (_chunks(q), _chunks(k), _chunks(v)))
    return _unchunk(o), r


def _retention_mixer(lat, ctx, decay_logit):
    qx, kx, vx = lat
    qh, kh, vh = ctx
    scale = HEAD_DIM ** -0.5
    kx, kh = kx * scale, kh * scale
    zero = jnp.zeros(qh.shape[:2] + (HEAD_DIM, HEAD_DIM), F32)
    out_x, out_h = 0.0, 0.0
    for d in range(2):
        rev = d == 1
        lg = jax.nn.log_sigmoid(decay_logit[d].astype(F32))
        oh, rh = _retention_dir(_flip(qh, rev, 2), _flip(kh, rev, 2), _flip(vh, rev, 2), lg, zero)
        ox, _ = _retention_dir(_flip(qx, rev, 2), _flip(kx, rev, 2), _flip(vx, rev, 2), lg, rh)
        out_h = out_h + _flip(oh, rev, 2)
        out_x = out_x + _flip(ox, rev, 2)
    return out_x, out_h


def _mlstm_dir(q, k, v, i_pre, f_pre, state):
    tril = jnp.tril(jnp.ones((CHUNK, CHUNK), dtype=bool))
    log_f = jax.nn.log_sigmoid(f_pre)

    def step(carry, inp):
        c_mem, n_mem, m_prev = carry
        qi, ki, vi, ii, lfi = inp
        b = jnp.cumsum(lfi, axis=-1)
        log_w = jnp.where(tril, b[..., :, None] - b[..., None, :] + ii[..., None, :], -jnp.inf)
        log_a = b + m_prev[..., None]
        m_t = jnp.maximum(log_a, jnp.max(log_w, axis=-1))
        w = jnp.exp(log_w - m_t[..., None])
        a = jnp.exp(log_a - m_t)
        s = jnp.einsum('bhid,bhjd->bhij', qi, ki) * w
        num = jnp.einsum('bhij,bhjv->bhiv', s, vi) + a[..., None] * jnp.einsum('bhid,bhdv->bhiv', qi, c_mem)
        den = jnp.sum(s, axis=-1) + a * jnp.einsum('bhid,bhd->bhi', qi, n_mem)
        h = num / jnp.maximum(jnp.abs(den), jnp.exp(-m_t))[..., None]
        b_end = b[..., -1:]
        log_w_end = b_end - b + ii
        m_new = jnp.maximum(b_end[..., 0] + m_prev, jnp.max(log_w_end, axis=-1))
        a_end = jnp.exp(b_end[..., 0] + m_prev - m_new)
        w_end = jnp.exp(log_w_end - m_new[..., None])
        c_mem = a_end[..., None, None] * c_mem + jnp.einsum('bhj,bhjd,bhjv->bhdv', w_end, ki, vi)
        n_mem = a_end[..., None] * n_mem + jnp.einsum('bhj,bhjd->bhd', w_end, ki)
        return (c_mem, n_mem, m_new), h

    state, h = lax.scan(step, state, (_chunks(q), _chunks(k), _chunks(v), _chunks(i_pre), _chunks(log_f)))
    return _unchunk(h), state


def _mlstm_mixer(lat, ctx, igate_b, fgate_b):
    qx, kx, vx, gx = lat
    qh, kh, vh, gh = ctx
    scale = HEAD_DIM ** -0.5
    kx, kh = kx * scale, kh * scale
    b, hh = qh.shape[:2]
    init = (jnp.zeros((b, hh, HEAD_DIM, HEAD_DIM), F32), jnp.zeros((b, hh, HEAD_DIM), F32), jnp.zeros((b, hh), F32))
    out_x, out_h = 0.0, 0.0
    for d in range(2):
        rev = d == 1
        ib = igate_b[d].astype(F32)[:, None]
        fb = fgate_b[d].astype(F32)[:, None]
        oh, st = _mlstm_dir(_flip(qh, rev, 2), _flip(kh, rev, 2), _flip(vh, rev, 2),
                            _flip(gh[d, 0] + ib, rev, 2), _flip(gh[d, 1] + fb, rev, 2), init)
        ox, _ = _mlstm_dir(_flip(qx, rev, 2), _flip(kx, rev, 2), _flip(vx, rev, 2),
                           _flip(gx[d, 0] + ib, rev, 2), _flip(gx[d, 1] + fb, rev, 2), st)
        out_h = out_h + _flip(oh, rev, 2)
        out_x = out_x + _flip(ox, rev, 2)
    return out_x, out_h


def _gates(t):
    b, l, _ = t.shape
    return t.reshape(b, l, 2, 2, MLSTM_HEADS).transpose(2, 3, 0, 4, 1).astype(F32)


def _token_mix(a_x, a_h, cos, sin, ctx_out, s5_lam_re, s5_lam_im, s5_log_step, s5_b_re, s5_b_im,
               s5_c_re, s5_c_im, s5_d, s5_w_glu, s5_b_glu, ret_decay_logit, ret_norm_w,
               mlstm_igate_b, mlstm_fgate_b, mlstm_norm_w):
    px = jnp.split(a_x, IN_SPLITS, axis=-1)
    ph = jnp.split(a_h, IN_SPLITS, axis=-1)
    s5x, s5h = _s5_mixer(px[0], ph[0], s5_lam_re, s5_lam_im, s5_log_step, s5_b_re, s5_b_im, s5_c_re, s5_c_im, s5_d)
    rx = jnp.split(px[1], 4, axis=-1)
    rh = jnp.split(ph[1], 4, axis=-1)
    lat_r = (_apply_rope(_heads(rx[0], RET_HEADS), cos, sin), _apply_rope(_heads(rx[1], RET_HEADS), cos, sin),
             _heads(rx[2], RET_HEADS))
    ctx_r = (_heads(rh[0], RET_HEADS), _heads(rh[1], RET_HEADS), _heads(rh[2], RET_HEADS))
    retx, reth = _retention_mixer(lat_r, ctx_r, ret_decay_logit)
    mx = jnp.split(px[2], 4, axis=-1)
    mh = jnp.split(ph[2], 4, axis=-1)
    lat_m = (_heads(mx[0], MLSTM_HEADS), _heads(mx[1], MLSTM_HEADS), _heads(mx[2], MLSTM_HEADS), _gates(px[3]))
    ctx_m = (_heads(mh[0], MLSTM_HEADS), _heads(mh[1], MLSTM_HEADS), _heads(mh[2], MLSTM_HEADS), _gates(ph[3]))
    mlx, mlh = _mlstm_mixer(lat_m, ctx_m, mlstm_igate_b, mlstm_fgate_b)

    def merge(s5y, rety, rgate, mly, ogate):
        return jnp.concatenate([
            _s5_glu(s5y, s5_w_glu, s5_b_glu),
            _head_norm(rety, ret_norm_w, True) * jax.nn.silu(rgate.astype(F32)),
            _head_norm(mly, mlstm_norm_w, False) * jax.nn.sigmoid(ogate.astype(F32)),
        ], axis=-1)

    y_x = merge(s5x, retx, rx[3], mlx, mx[3])
    y_h = merge(s5h, reth, rh[3], mlh, mh[3]) if ctx_out else None
    return y_x, y_h


def _sq_relu_mlp(h, w1, w2):
    return jnp.square(jax.nn.relu(h @ w1)) @ w2


def setup_inputs(seed: int = 0) -> dict:
    key = jax.random.key(seed)
    keys = iter(jax.random.split(key, 32))

    def normal(shape, scale):
        return jax.random.normal(next(keys), shape, F32) * scale

    g, p, n, h = S5_GROUPS, S5_STATE, S5_GROUP, RET_HEADS
    x = normal((BATCH, SEQ, D_MODEL), 1.0)
    c = normal((BATCH, D_MODEL), 1.0)
    ctx = normal((BATCH, CTX_LEN, D_MODEL), 1.0)
    c_ctx = normal((D_MODEL,), 1.0)
    w_mod = normal((DEPTH, D_MODEL, 6 * D_MODEL), 0.5 * D_MODEL ** -0.5)
    b_mod = normal((DEPTH, 6 * D_MODEL), 0.02)
    norm1_w = 1.0 + normal((DEPTH, D_MODEL), 0.02)
    norm2_w = 1.0 + normal((DEPTH, D_MODEL), 0.02)
    w_in = normal((DEPTH, D_MODEL, IN_WIDTH), D_MODEL ** -0.5)
    w_out = normal((DEPTH, MIX_WIDTH, D_MODEL), MIX_WIDTH ** -0.5)
    s5_lam_re = -0.5 + normal((DEPTH, 2, g, p), 0.01)
    s5_lam_im = jnp.pi * jnp.arange(p, dtype=F32) + normal((DEPTH, 2, g, p), 0.01)
    s5_log_step = jax.random.uniform(next(keys), (DEPTH, 2, g), F32, math.log(S5_DT_MIN), math.log(S5_DT_MAX))
    s5_b_re = normal((DEPTH, 2, g, p, n), (2.0 * n) ** -0.5)
    s5_b_im = normal((DEPTH, 2, g, p, n), (2.0 * n) ** -0.5)
    s5_c_re = normal((DEPTH, 2, g, n, p), p ** -0.5)
    s5_c_im = normal((DEPTH, 2, g, n, p), p ** -0.5)
    s5_d = normal((DEPTH, S5_WIDTH), 1.0)
    s5_w_glu = normal((DEPTH, S5_WIDTH, 2 * S5_WIDTH), S5_WIDTH ** -0.5)
    s5_b_glu = normal((DEPTH, 2 * S5_WIDTH), 0.02)
    expo = 5.0 + jnp.arange(h, dtype=F32)
    ret_decay_logit = jnp.log(2.0 ** expo - 1.0) + normal((DEPTH, 2, h), 0.01)
    ret_norm_w = 1.0 + normal((DEPTH, RET_WIDTH), 0.02)
    mlstm_igate_b = normal((DEPTH, 2, MLSTM_HEADS), 0.1)
    mlstm_fgate_b = jnp.linspace(3.0, 6.0, MLSTM_HEADS, dtype=F32) + normal((DEPTH, 2, MLSTM_HEADS), 0.1)
    mlstm_norm_w = 1.0 + normal((DEPTH, MLSTM_WIDTH), 0.02)
    w_ff1 = normal((DEPTH, D_MODEL, D_FF), D_MODEL ** -0.5)
    w_ff2 = normal((DEPTH, D_FF, D_MODEL), D_FF ** -0.5)
    norm_f_w = 1.0 + normal((D_MODEL,), 0.02)
    return {'x': x, 'c': c, 'ctx': ctx, 'c_ctx': c_ctx, 'w_mod': w_mod, 'b_mod': b_mod,
            'norm1_w': norm1_w, 'norm2_w': norm2_w, 'w_in': w_in, 'w_out': w_out,
            's5_lam_re': s5_lam_re, 's5_lam_im': s5_lam_im, 's5_log_step': s5_log_step,
            's5_b_re': s5_b_re, 's5_b_im': s5_b_im, 's5_c_re': s5_c_re, 's5_c_im': s5_c_im,
            's5_d': s5_d, 's5_w_glu': s5_w_glu, 's5_b_glu': s5_b_glu,
            'ret_decay_logit': ret_decay_logit, 'ret_norm_w': ret_norm_w,
            'mlstm_igate_b': mlstm_igate_b, 'mlstm_fgate_b': mlstm_fgate_b, 'mlstm_norm_w': mlstm_norm_w,
            'w_ff1': w_ff1, 'w_ff2': w_ff2, 'norm_f_w': norm_f_w}


def reference(x, c, ctx, c_ctx, w_mod, b_mod, norm1_w, norm2_w, w_in, w_out,
              s5_lam_re, s5_lam_im, s5_log_step, s5_b_re, s5_b_im, s5_c_re, s5_c_im,
              s5_d, s5_w_glu, s5_b_glu, ret_decay_logit, ret_norm_w,
              mlstm_igate_b, mlstm_fgate_b, mlstm_norm_w, w_ff1, w_ff2, norm_f_w):
    dt = x.dtype
    n_lat = x.shape[1]
    rows_count = n_lat // GRID_W
    rows = jnp.repeat(jnp.arange(rows_count, dtype=F32), GRID_W)
    cols = jnp.tile(jnp.arange(GRID_W, dtype=F32), rows_count)
    cos, sin = _rope_2d_tables(rows, cols)
    silu_c = jax.nn.silu(c)[:, None, :]
    silu_cc = jax.nn.silu(c_ctx)[None, None, :]
    h = ctx
    for l in range(DEPTH):
        last = l == DEPTH - 1
        mod_x = jnp.split(silu_c @ w_mod[l] + b_mod[l], 6, axis=-1)
        mod_h = jnp.split(silu_cc @ w_mod[l] + b_mod[l], 6, axis=-1)
        a_x = _modulate(_rmsnorm(x, norm1_w[l]), mod_x[0], mod_x[1]) @ w_in[l]
        a_h = _modulate(_rmsnorm(h, norm1_w[l]), mod_h[0], mod_h[1]) @ w_in[l]
        y_x, y_h = _token_mix(a_x, a_h, cos, sin, not last,
                              s5_lam_re[l], s5_lam_im[l], s5_log_step[l], s5_b_re[l], s5_b_im[l],
                              s5_c_re[l], s5_c_im[l], s5_d[l], s5_w_glu[l], s5_b_glu[l],
                              ret_decay_logit[l], ret_norm_w[l],
                              mlstm_igate_b[l], mlstm_fgate_b[l], mlstm_norm_w[l])
        x = x + mod_x[2] * (y_x.astype(dt) @ w_out[l])
        x = x + mod_x[5] * _sq_relu_mlp(_modulate(_rmsnorm(x, norm2_w[l]), mod_x[3], mod_x[4]), w_ff1[l], w_ff2[l])
        if not last:
            h = h + mod_h[2] * (y_h.astype(dt) @ w_out[l])
            h = h + mod_h[5] * _sq_relu_mlp(_modulate(_rmsnorm(h, norm2_w[l]), mod_h[3], mod_h[4]), w_ff1[l], w_ff2[l])
    return _rmsnorm(x, norm_f_w)
```

```cpp
#include <hip/hip_runtime.h>
#include <hip/hip_cooperative_groups.h>
#include <cstdio>
#include <cstdint>
namespace cg = cooperative_groups;
namespace pg8 {
#define PG8_LAS __attribute__((address_space(3)))
typedef unsigned short bf16_t;
typedef short bf16x8 __attribute__((ext_vector_type(8)));
typedef float f32x4 __attribute__((ext_vector_type(4)));
typedef unsigned u32x4 __attribute__((ext_vector_type(4)));
constexpr int BM = 256, BK = 64, HALF = 128, HTB = HALF * BK * 2  , STAGE_BYTES = 8 * HTB, NXCD = 8, WGM = 2;

__host__ __device__ __forceinline__ int lds_byte(int r, int c) { const int st = (r >> 4) * 2 + (c >> 5), rr = r & 15, cc = c & 31, ob = rr * 64 + cc * 2; return st * 1024 + (ob ^ (((ob >> 9) & 1) << 5)); }
__host__ __device__ __forceinline__ void stage_rc(int b, int& R, int& C) { const int st = b / 1024, sb = b % 1024, swz = sb ^ (((sb >> 9) & 1) << 5); R = (st >> 1) * 16 + swz / 64; C = (st & 1) * 32 + (swz % 64) / 2; }
__host__ __device__ __forceinline__ int perm32(int rho) { const int n = rho >> 4, i = rho & 15; return 8 * (i >> 2) + 4 * n + (i & 3); }

struct Unit { int pm, pn, k0; };
struct Gemm { const bf16_t* A; const bf16_t* Bt; int M, N, K, ld; };

struct StaticOrder {
    int nM, nN, nwg, G, c, limit;
    __host__ __device__ void init(int M, int N, int G_, int c_) { nM = M / BM; nN = N / BM; nwg = nM * nN; G = G_; c = c_; limit = nwg; }
    __host__ __device__ void map(int wgid_in, Unit& u) const { int wgid = wgid_in; { const int q = nwg / NXCD, r = nwg % NXCD, xcd = wgid % NXCD, off = wgid / NXCD; wgid = (xcd < r ? xcd * (q + 1) : r * (q + 1) + (xcd - r) * q) + off; }
        const int nig = WGM * nN, gid = wgid / nig, fm = gid * WGM, gsz = (nM - fm) < WGM ? (nM - fm) : WGM; u.pm = fm + ((wgid % nig) % gsz); u.pn = (wgid % nig) / gsz; u.k0 = 0; }
    __host__ __device__ bool next(int i, Unit& u) const {
        const long L = (long)i * G + c; if (L >= limit) return false; u.k0 = 0;
        int wgid = (int)L; { const int q = nwg / NXCD, r = nwg % NXCD, xcd = wgid % NXCD, off = wgid / NXCD; wgid = (xcd < r ? xcd * (q + 1) : r * (q + 1) + (xcd - r) * q) + off; }
        const int nig = WGM * nN, gid = wgid / nig, fm = gid * WGM, gsz = (nM - fm) < WGM ? (nM - fm) : WGM;
        u.pm = fm + ((wgid % nig) % gsz); u.pn = (wgid % nig) / gsz; return true;
    }
    __device__ __forceinline__ void a_ready(const Unit&) const {}
    __device__ __forceinline__ void done(const Unit&) const {}
};

__device__ __forceinline__ unsigned cvt_pk_bf16(float lo, float hi) { unsigned r; asm volatile("v_cvt_pk_bf16_f32 %0, %1, %2" : "=v"(r) : "v"(lo), "v"(hi)); return r; }
template <class Epi, class Sched, bool ALIGN_EPI = false, bool SP2 = false>
__device__ __forceinline__ void gemm_phase(PG8_LAS unsigned char* lds, const Gemm g, const Sched& S, const Epi& E) {
    int tid_ = threadIdx.x; asm volatile("" : "+v"(tid_));
    const int tid = tid_, wid = __builtin_amdgcn_readfirstlane(tid >> 6), lane = tid & 63, wr = wid >> 2, wc = wid & 3, fr = lane & 15, fq = lane >> 4;
    const int K = g.ld, nt = g.K / BK;
    unsigned voffA[2], voffB[2];
#pragma unroll
    for (int i = 0; i < 2; ++i) { int R, C; stage_rc(tid * 16 + i * 8192, R, C); const int Rb = Epi::PERM ? ((R & ~31) + perm32(R & 31)) : R;
        voffA[i] = (unsigned)(R * K + C) * 2u; voffB[i] = (unsigned)(Rb * K + C) * 2u; }
    const size_t kstep = (size_t)(BK * 2);
    const size_t hstep = (size_t)HALF * K * 2;
    const size_t tstep = 2 * hstep;
    const unsigned ldsw = (unsigned)wid * 1024u;
    const int aoff = lds_byte(wr * 64 + fr, fq * 8), boff = lds_byte(wc * 32 + fr, fq * 8);
#define PG8_SA(b, h) (((b) * 2 + (h)) * HTB)
#define PG8_SB(b, h) ((4 + (b) * 2 + (h)) * HTB)
#define PG8_STAGE(bufoff, gbase, voff) do { _Pragma("unroll") for (int _i = 0; _i < 2; ++_i) \
        __builtin_amdgcn_global_load_lds((const unsigned*)((const char*)(gbase) + (voff)[_i]), (PG8_LAS unsigned*)(lds + (bufoff) + ldsw + _i * 8192), 16, 0, 0); } while (0)
#define PG8_LDA(dst, b, h) do { _Pragma("unroll") for (int m = 0; m < 4; ++m) _Pragma("unroll") for (int k = 0; k < 2; ++k) dst[m][k] = *(const PG8_LAS bf16x8*)(lds + PG8_SA(b, h) + aoff + m * 2048 + k * 1024); } while (0)
#define PG8_LDB(dst, b, h) do { _Pragma("unroll") for (int n = 0; n < 2; ++n) _Pragma("unroll") for (int k = 0; k < 2; ++k) dst[n][k] = *(const PG8_LAS bf16x8*)(lds + PG8_SB(b, h) + boff + n * 2048 + k * 1024); } while (0)
#define PG8_MMA(ai, bj, At, Bt) do { __builtin_amdgcn_s_setprio(1); _Pragma("unroll") for (int m = 0; m < 4; ++m) _Pragma("unroll") for (int n = 0; n < 2; ++n) _Pragma("unroll") for (int k = 0; k < 2; ++k) \
        acc[ai][bj][m][n] = __builtin_amdgcn_mfma_f32_16x16x32_bf16(Bt[n][k], At[m][k], acc[ai][bj][m][n], 0, 0, 0); __builtin_amdgcn_s_setprio(0); } while (0)
#define PG8_WAIT_V(n) asm volatile("s_waitcnt vmcnt(" #n ")" ::: "memory")
#define PG8_WAIT_L(n) asm volatile("s_waitcnt lgkmcnt(" #n ")" ::: "memory")
#define PG8_BAR __builtin_amdgcn_s_barrier()
#define PG8_SCHED __builtin_amdgcn_sched_barrier(0)
    Unit cur, nxt; int ui = 0;
    if (!S.next(0, cur)) return;
    f32x4 acc[2][2][4][2];
#pragma unroll
    for (int a = 0; a < 2; ++a)
#pragma unroll
        for (int b = 0; b < 2; ++b)
#pragma unroll
            for (int m = 0; m < 4; ++m)
#pragma unroll
                for (int n = 0; n < 2; ++n) acc[a][b][m][n] = (f32x4){0.f, 0.f, 0.f, 0.f};
    bf16x8 At[4][2], B0[2][2], B1[2][2];
    const char* cA = (const char*)g.A + (size_t)cur.pm * tstep + (size_t)cur.k0 * 2; const char* cB = (const char*)g.Bt + (size_t)cur.pn * tstep + (size_t)cur.k0 * 2;
    S.a_ready(cur);
    if constexpr (SP2) {
        PG8_STAGE(PG8_SB(0, 0), cB, voffB); PG8_STAGE(PG8_SB(0, 1), cB + hstep, voffB); PG8_STAGE(PG8_SA(0, 0), cA, voffA); PG8_STAGE(PG8_SA(0, 1), cA + hstep, voffA);
        if (wr == 1) PG8_BAR;
        PG8_WAIT_V(2); PG8_BAR;
        PG8_STAGE(PG8_SB(1, 0), cB + kstep, voffB); PG8_STAGE(PG8_SA(1, 0), cA + kstep, voffA); PG8_STAGE(PG8_SB(1, 1), cB + hstep + kstep, voffB);
        PG8_WAIT_V(6); PG8_BAR;
    } else {
        PG8_STAGE(PG8_SB(0, 0), cB, voffB); PG8_STAGE(PG8_SA(0, 0), cA, voffA); PG8_STAGE(PG8_SB(0, 1), cB + hstep, voffB); PG8_STAGE(PG8_SA(0, 1), cA + hstep, voffA);
        if (wr == 1) PG8_BAR;
        PG8_WAIT_V(4); PG8_BAR;
        PG8_STAGE(PG8_SB(1, 0), cB + kstep, voffB); PG8_STAGE(PG8_SA(1, 0), cA + kstep, voffA); PG8_STAGE(PG8_SB(1, 1), cB + hstep + kstep, voffB);
        PG8_WAIT_V(6); PG8_BAR;
    }
    for (;;) {
        const bool has_next = S.next(ui + 1, nxt);
        const char* nA = has_next ? (const char*)g.A + (size_t)nxt.pm * tstep + (size_t)nxt.k0 * 2 : cA; const char* nB = has_next ? (const char*)g.Bt + (size_t)nxt.pn * tstep + (size_t)nxt.k0 * 2 : cB;
        for (int t = 0; t < nt; t += 2) {
            const bool last = (t == nt - 2);
            const char* a1 = cA + (size_t)(t + 1) * kstep;
            const char* a2 = last ? nA : cA + (size_t)(t + 2) * kstep; const char* b2 = last ? nB : cB + (size_t)(t + 2) * kstep;
            const char* a3 = a2 + kstep; const char* b3 = b2 + kstep;
            if (last && has_next) S.a_ready(nxt);
            if constexpr (SP2) {
            PG8_LDB(B0, 0, 0); PG8_LDB(B1, 0, 1); PG8_SCHED; PG8_LDA(At, 0, 0); PG8_STAGE(PG8_SA(1, 1), a1 + hstep, voffA);
            PG8_WAIT_V(8); PG8_WAIT_L(0); PG8_BAR; PG8_MMA(0, 0, At, B0); PG8_MMA(0, 1, At, B1); PG8_BAR; PG8_SCHED;
            PG8_LDA(At, 0, 1); PG8_STAGE(PG8_SB(0, 0), b2, voffB); PG8_STAGE(PG8_SB(0, 1), b2 + hstep, voffB); PG8_STAGE(PG8_SA(0, 0), a2, voffA);
            PG8_WAIT_V(8); PG8_WAIT_L(0); PG8_BAR; PG8_MMA(1, 0, At, B0); PG8_MMA(1, 1, At, B1); PG8_BAR; PG8_SCHED;
            PG8_LDB(B0, 1, 0); PG8_LDB(B1, 1, 1); PG8_SCHED; PG8_LDA(At, 1, 0); PG8_STAGE(PG8_SA(0, 1), a2 + hstep, voffA);
            PG8_WAIT_V(8); PG8_WAIT_L(0); PG8_BAR; PG8_MMA(0, 0, At, B0); PG8_MMA(0, 1, At, B1); PG8_BAR; PG8_SCHED;
            PG8_LDA(At, 1, 1); PG8_STAGE(PG8_SB(1, 0), b3, voffB); PG8_STAGE(PG8_SB(1, 1), b3 + hstep, voffB); PG8_STAGE(PG8_SA(1, 0), a3, voffA);
            PG8_WAIT_V(8); PG8_WAIT_L(0); PG8_BAR; PG8_MMA(1, 0, At, B0); PG8_MMA(1, 1, At, B1); PG8_BAR; PG8_SCHED;
            } else {
            PG8_LDB(B0, 0, 0); PG8_SCHED; PG8_LDA(At, 0, 0); PG8_STAGE(PG8_SA(1, 1), a1 + hstep, voffA);
            PG8_WAIT_L(8); PG8_BAR; PG8_WAIT_L(0); PG8_MMA(0, 0, At, B0); PG8_BAR; PG8_SCHED;
            PG8_LDB(B1, 0, 1); PG8_STAGE(PG8_SB(0, 0), b2, voffB);
            PG8_BAR; PG8_WAIT_L(0); PG8_MMA(0, 1, At, B1); PG8_BAR;
            PG8_LDA(At, 0, 1); PG8_STAGE(PG8_SA(0, 0), a2, voffA);
            PG8_BAR; PG8_WAIT_L(0); PG8_MMA(1, 0, At, B0); PG8_BAR; PG8_SCHED;
            PG8_STAGE(PG8_SB(0, 1), b2 + hstep, voffB);
            PG8_WAIT_V(6); PG8_BAR; PG8_MMA(1, 1, At, B1); PG8_BAR;
            PG8_LDB(B0, 1, 0); PG8_SCHED; PG8_LDA(At, 1, 0); PG8_STAGE(PG8_SA(0, 1), a2 + hstep, voffA);
            PG8_WAIT_L(8); PG8_BAR; PG8_WAIT_L(0); PG8_MMA(0, 0, At, B0); PG8_BAR; PG8_SCHED;
            PG8_LDB(B1, 1, 1); PG8_STAGE(PG8_SB(1, 0), b3, voffB);
            PG8_BAR; PG8_WAIT_L(0); PG8_MMA(0, 1, At, B1); PG8_BAR;
            PG8_LDA(At, 1, 1); PG8_STAGE(PG8_SA(1, 0), a3, voffA);
            PG8_BAR; PG8_WAIT_L(0); PG8_MMA(1, 0, At, B0); PG8_BAR; PG8_SCHED;
            PG8_STAGE(PG8_SB(1, 1), b3 + hstep, voffB);
            PG8_WAIT_V(6); PG8_BAR; PG8_MMA(1, 1, At, B1); PG8_BAR;
            }
        }
        if constexpr (ALIGN_EPI) { if (wr == 0) PG8_BAR; }
        if constexpr (!Epi::AFTER_DRAIN) { E(acc, cur, wr, wc, fr, fq); S.done(cur); }
        if (!has_next) break;
#pragma unroll
        for (int a = 0; a < 2; ++a)
#pragma unroll
            for (int b = 0; b < 2; ++b)
#pragma unroll
                for (int m = 0; m < 4; ++m)
#pragma unroll
                    for (int n = 0; n < 2; ++n) acc[a][b][m][n] = (f32x4){0.f, 0.f, 0.f, 0.f};
        cur = nxt; cA = nA; cB = nB; ++ui;
        if constexpr (ALIGN_EPI) { if (wr == 1) PG8_BAR; }
    }
    PG8_WAIT_V(0);
    if constexpr (!ALIGN_EPI) { if (wr == 0) PG8_BAR; }
    PG8_BAR;
    if constexpr (Epi::AFTER_DRAIN) { E.fused(acc, cur, wr, wc, fr, fq, lds, wid, lane); S.done(cur); }
#undef PG8_SA
#undef PG8_SB
#undef PG8_STAGE
#undef PG8_LDA
#undef PG8_LDB
#undef PG8_MMA
#undef PG8_WAIT_V
#undef PG8_WAIT_L
#undef PG8_BAR
#undef PG8_SCHED
}
}

#define LAS __attribute__((address_space(3)))
typedef unsigned short bf16_t;
typedef short bf16x8 __attribute__((ext_vector_type(8)));
typedef short s16x4 __attribute__((ext_vector_type(4)));
typedef float f32x4 __attribute__((ext_vector_type(4)));
typedef unsigned u32x4 __attribute__((ext_vector_type(4)));
typedef unsigned u32x2 __attribute__((ext_vector_type(2)));

constexpr int DM = 2048, NBATCH = 4, SEQ = 2048, CTXL = 256;
constexpr int MLAT = NBATCH * SEQ, MCTX = NBATCH * CTXL, MTOT = MLAT + MCTX;
constexpr int INW = 6680, INWP = 6912, AW = 6656, DFF = 8192, MODW = 6 * DM;
constexpr int NHEAD = 6;
constexpr int COL_R = 512, COL_M = 3584;
constexpr int NPB = 18, NSC = 36;
constexpr float EPSN = 1e-6f;
constexpr int NWAVES = 8, NTHR = 512;
constexpr int LDS_BYTES = 148480, XB_LDS_OFF = 147456;

constexpr size_t MiB = 1u << 20;
constexpr size_t WS_WIN = 0;
constexpr size_t WS_WOUT = 54 * MiB;
constexpr size_t WS_WGLU = 70 * MiB;
constexpr size_t WS_WFF1 = 72 * MiB;
constexpr size_t WS_WFF2 = 136 * MiB;
constexpr size_t WS_MOD = 200 * MiB;
constexpr size_t WS_ROPE = 201 * MiB;
constexpr size_t WS_S5T = 202 * MiB;
constexpr size_t WS_X = 204 * MiB;
constexpr size_t WS_XN = 276 * MiB;
constexpr size_t WS_Y = 312 * MiB;
constexpr size_t WS_G = 348 * MiB;
constexpr size_t WS_GATES = 357 * MiB;
constexpr size_t WS_SMALL = 358 * MiB;
constexpr size_t WS_ES = 362 * MiB;
constexpr size_t WS_XIN = 367 * MiB;
constexpr size_t WS_A = 372 * MiB;
constexpr size_t WS_KV = 489 * MiB;
constexpr size_t WS_CB = 543 * MiB;
constexpr size_t WS_H = WS_A;
constexpr size_t WS_CTL = 597 * MiB;
constexpr size_t WS_PART = 598 * MiB;
constexpr size_t WS_FUSE = 662 * MiB;
constexpr size_t FU_BIAS2 = 0, FU_BIAS1 = 327680, FU_RSS = 327680 + 138240;
constexpr size_t WS_GS = 663 * MiB;
constexpr size_t WS_END = 666 * MiB;
constexpr size_t S5_ABR = 0, S5_ABI = 32768, S5_A64R = 65536, S5_A64I = 98304, S5_BBT = 131072  , S5_CT = 131072 + 524288;
constexpr size_t SM_KN = 0, SM_NBEF = 1 * MiB, SM_SC = 2 * MiB, SM_MPREV = 3 * MiB;

__device__ __forceinline__ unsigned f2bf(float f) { unsigned u = __builtin_bit_cast(unsigned, f); return (u + 0x7fffu + ((u >> 16) & 1u)) >> 16; }
typedef __bf16 hwbf16x2_t __attribute__((ext_vector_type(2)));
typedef float hwf32x2_t __attribute__((ext_vector_type(2)));
__device__ __forceinline__ unsigned pk2(float lo, float hi) { const hwf32x2_t v = {lo, hi}; const hwbf16x2_t b = __builtin_convertvector(v, hwbf16x2_t); return __builtin_bit_cast(unsigned, b); }
__device__ __forceinline__ float bflo(unsigned u) { return __builtin_bit_cast(float, u << 16); }
__device__ __forceinline__ float bfhi(unsigned u) { return __builtin_bit_cast(float, u & 0xffff0000u); }
__device__ __forceinline__ float bf1(bf16_t h) { return __builtin_bit_cast(float, (unsigned)h << 16); }
__device__ __forceinline__ float sigmoidf_(float x) { return 1.f / (1.f + __expf(-x)); }
__device__ __forceinline__ float logsigf_(float x) { return fminf(x, 0.f) - log1pf(expf(-fabsf(x))); }
__device__ __forceinline__ f32x4 mfma16(bf16x8 a, bf16x8 b, f32x4 c) { return __builtin_amdgcn_mfma_f32_16x16x32_bf16(a, b, c, 0, 0, 0); }

__device__ __forceinline__ int pb_row(int b, int pb) { return pb < 2 ? MLAT + b * CTXL + pb * 128 : b * SEQ + (pb - 2) * 128; }
__device__ __forceinline__ int sc_row(int b, int sc) { return sc < 4 ? MLAT + b * CTXL + sc * 64 : b * SEQ + (sc - 4) * 64; }
__device__ __forceinline__ int seq_pb(int d, int k) { return d == 0 ? k : (k < 2 ? 1 - k : 19 - k); }
__device__ __forceinline__ int seq_sc(int d, int k) { return d == 0 ? k : (k < 4 ? 3 - k : 39 - k); }

struct Args { const float* in[28]; float* out; unsigned char* ws; int ph_lo, ph_hi; };

struct EpiIn {
    static constexpr bool PERM = true, AFTER_DRAIN = false;
    bf16_t* A; float* gates; const float* rss; const float* bias;
    __device__ __forceinline__ void operator()(const f32x4 (&acc)[2][2][4][2], const pg8::Unit& u, int wr, int wc, int fr, int fq) const {
        const int row0 = u.pm * 256 + wr * 64 + fr, col0 = u.pn * 256 + wc * 32 + 8 * fq;
        const int mr = u.pm < 32 ? (u.pm >> 3) : 4;
        float rstd[2][4];
#pragma unroll
        for (int ai = 0; ai < 2; ++ai)
#pragma unroll
            for (int m = 0; m < 4; ++m) rstd[ai][m] = rss ? rsqrtf(rss[row0 + ai * 128 + m * 16] * (1.f / DM) + EPSN) : 1.f;
#pragma unroll
        for (int bj = 0; bj < 2; ++bj) {
            f32x4 b0 = (f32x4){0.f, 0.f, 0.f, 0.f}, b1 = b0;
            if (rss) { const float* bp = bias + (size_t)mr * INWP + col0 + bj * 128; b0 = *(const f32x4*)bp; b1 = *(const f32x4*)(bp + 4); }
#pragma unroll
            for (int ai = 0; ai < 2; ++ai)
#pragma unroll
                for (int m = 0; m < 4; ++m) { const int row = row0 + ai * 128 + m * 16;
                    const f32x4 v0 = acc[ai][bj][m][0] * rstd[ai][m] + b0, v1 = acc[ai][bj][m][1] * rstd[ai][m] + b1;
                    if (u.pn < 26) { u32x4 w; w.x = pk2(v0[0], v0[1]); w.y = pk2(v0[2], v0[3]); w.z = pk2(v1[0], v1[1]); w.w = pk2(v1[2], v1[3]);
                        *(u32x4*)(A + (size_t)row * AW + col0 + bj * 128) = w; }
                    else if (bj == 0 && wc == 0 && fq < 3) { float* gp = gates + (size_t)row * 24 + 8 * fq; *(f32x4*)gp = v0; *(f32x4*)(gp + 4) = v1; } }
        }
    }
};
struct EpiGlu {
    static constexpr bool PERM = true, AFTER_DRAIN = false;
    bf16_t* Y; const float* bias;
    __device__ __forceinline__ void operator()(const f32x4 (&acc)[2][2][4][2], const pg8::Unit& u, int wr, int wc, int fr, int fq) const {
        const int row0 = u.pm * 256 + wr * 64 + fr, colo = u.pn * 128 + wc * 32 + 8 * fq;
        const f32x4 b00 = *(const f32x4*)(bias + colo), b01 = *(const f32x4*)(bias + colo + 4), b10 = *(const f32x4*)(bias + 512 + colo), b11 = *(const f32x4*)(bias + 512 + colo + 4);
#pragma unroll
        for (int ai = 0; ai < 2; ++ai)
#pragma unroll
            for (int m = 0; m < 4; ++m) {
                float o[8];
#pragma unroll
                for (int e = 0; e < 4; ++e) { o[e] = (acc[ai][0][m][0][e] + b00[e]) * sigmoidf_(acc[ai][1][m][0][e] + b10[e]); o[4 + e] = (acc[ai][0][m][1][e] + b01[e]) * sigmoidf_(acc[ai][1][m][1][e] + b11[e]); }
                u32x4 w; w.x = pk2(o[0], o[1]); w.y = pk2(o[2], o[3]); w.z = pk2(o[4], o[5]); w.w = pk2(o[6], o[7]);
                *(u32x4*)(Y + (size_t)(row0 + ai * 128 + m * 16) * DM + colo) = w; }
    }
};
struct EpiRes {
    static constexpr bool PERM = true, AFTER_DRAIN = false;
    float* X; const float* resL; const float* resC; const float* modv;
    bf16_t* XS; const float* nw; const float* scv; float* rss;
    __device__ __forceinline__ void operator()(const f32x4 (&acc)[2][2][4][2], const pg8::Unit& u, int wr, int wc, int fr, int fq) const {
        const int row0 = u.pm * 256 + wr * 64 + fr, col0 = u.pn * 256 + wc * 32 + 8 * fq;
        const int mr = u.pm < 32 ? (u.pm >> 3) : 4;
        const float* mv = modv + (size_t)mr * MODW + col0;
        float rs[2][4];
#pragma unroll
        for (int ai = 0; ai < 2; ++ai)
#pragma unroll
            for (int m = 0; m < 4; ++m) rs[ai][m] = 0.f;
#pragma unroll
        for (int bj = 0; bj < 2; ++bj) {
            const f32x4 g0 = *(const f32x4*)(mv + bj * 128), g1 = *(const f32x4*)(mv + bj * 128 + 4);
            f32x4 c0 = (f32x4){0.f, 0.f, 0.f, 0.f}, c1 = c0;
            if (XS) { const float* sp = scv + (size_t)mr * MODW + col0 + bj * 128; const float* np = nw + col0 + bj * 128;
                c0 = *(const f32x4*)np * (*(const f32x4*)sp + 1.f); c1 = *(const f32x4*)(np + 4) * (*(const f32x4*)(sp + 4) + 1.f); }
#pragma unroll
            for (int ai = 0; ai < 2; ++ai)
#pragma unroll
                for (int m = 0; m < 4; ++m) { const int row = row0 + ai * 128 + m * 16;
                    const float* src = (row < MLAT ? resL + (size_t)row * DM : resC + (size_t)(row - MLAT) * DM) + col0 + bj * 128;
                    float* dst = X + (size_t)row * DM + col0 + bj * 128;
                    const f32x4 x0 = __builtin_nontemporal_load((const f32x4*)src) + g0 * acc[ai][bj][m][0], x1 = __builtin_nontemporal_load((const f32x4*)(src + 4)) + g1 * acc[ai][bj][m][1];
                    *(f32x4*)dst = x0; *(f32x4*)(dst + 4) = x1;
                    if (XS) { rs[ai][m] += (x0[0] * x0[0] + x0[1] * x0[1]) + (x0[2] * x0[2] + x0[3] * x0[3]) + (x1[0] * x1[0] + x1[1] * x1[1]) + (x1[2] * x1[2] + x1[3] * x1[3]);
                        const f32x4 y0 = x0 * c0, y1 = x1 * c1; u32x4 w; w.x = pk2(y0[0], y0[1]); w.y = pk2(y0[2], y0[3]); w.z = pk2(y1[0], y1[1]); w.w = pk2(y1[2], y1[3]);
                        *(u32x4*)(XS + (size_t)row * DM + col0 + bj * 128) = w; } }
        }
        if (XS) {
#pragma unroll
            for (int ai = 0; ai < 2; ++ai)
#pragma unroll
                for (int m = 0; m < 4; ++m) { float v = rs[ai][m]; v += __shfl_xor(v, 16); v += __shfl_xor(v, 32);
                    if (fq == 0) __hip_atomic_fetch_add(rss + row0 + ai * 128 + m * 16, v, __ATOMIC_RELAXED, __HIP_MEMORY_SCOPE_AGENT); }
        }
    }
};
struct EpiFF1 {
    static constexpr bool PERM = true, AFTER_DRAIN = false;
    bf16_t* H; const float* rss; const float* bias;
    __device__ __forceinline__ void operator()(const f32x4 (&acc)[2][2][4][2], const pg8::Unit& u, int wr, int wc, int fr, int fq) const {
        const int row0 = u.pm * 256 + wr * 64 + fr, col0 = u.pn * 256 + wc * 32 + 8 * fq;
        const int mr = u.pm < 32 ? (u.pm >> 3) : 4;
        float rstd[2][4];
#pragma unroll
        for (int ai = 0; ai < 2; ++ai)
#pragma unroll
            for (int m = 0; m < 4; ++m) rstd[ai][m] = rsqrtf(rss[row0 + ai * 128 + m * 16] * (1.f / DM) + EPSN);
#pragma unroll
        for (int bj = 0; bj < 2; ++bj) { const float* bp = bias + (size_t)mr * DFF + col0 + bj * 128; const f32x4 b0 = *(const f32x4*)bp, b1 = *(const f32x4*)(bp + 4);
#pragma unroll
            for (int ai = 0; ai < 2; ++ai)
#pragma unroll
                for (int m = 0; m < 4; ++m) { f32x4 v0 = acc[ai][bj][m][0] * rstd[ai][m] + b0, v1 = acc[ai][bj][m][1] * rstd[ai][m] + b1;
#pragma unroll
                    for (int e = 0; e < 4; ++e) { const float a = fmaxf(v0[e], 0.f), b = fmaxf(v1[e], 0.f); v0[e] = a * a; v1[e] = b * b; }
                    u32x4 w; w.x = pk2(v0[0], v0[1]); w.y = pk2(v0[2], v0[3]); w.z = pk2(v1[0], v1[1]); w.w = pk2(v1[2], v1[3]);
                    *(u32x4*)(H + (size_t)(row0 + ai * 128 + m * 16) * DFF + col0 + bj * 128) = w; } }
    }
};

__device__ __forceinline__ void p0_transpose_item(const float* W, int K, int Nsrc, bf16_t* WT, int kb, int n0src, int outrow0, LAS float* scr, int lane) {
    const int k0 = 64 * kb, nn = n0src + (lane & 31);
#pragma unroll
    for (int i = 0; i < 32; ++i) { const int kk = 2 * i + (lane >> 5); scr[kk * 33 + (lane & 31)] = nn < Nsrc ? __builtin_nontemporal_load(W + (size_t)(k0 + kk) * Nsrc + nn) : 0.f; }
    asm volatile("s_waitcnt lgkmcnt(0)" ::: "memory");
    const int c = lane & 7;
#pragma unroll
    for (int j = 0; j < 4; ++j) { const int n = (lane >> 3) + 8 * j; const LAS float* s = scr + (8 * c) * 33 + n;
        u32x4 o; o.x = pk2(s[0 * 33], s[1 * 33]); o.y = pk2(s[2 * 33], s[3 * 33]); o.z = pk2(s[4 * 33], s[5 * 33]); o.w = pk2(s[6 * 33], s[7 * 33]);
        *(u32x4*)(WT + (size_t)(outrow0 + n) * K + k0 + 8 * c) = o; }
    asm volatile("s_waitcnt lgkmcnt(0)" ::: "memory");
}

__device__ __forceinline__ void phase_p0(const Args& a, LAS unsigned char* L, int tid, int lane, int wave) {
    unsigned char* ws = a.ws;
    const int G = gridDim.x, gw = blockIdx.x * NWAVES + wave, NGW = G * NWAVES, gt = blockIdx.x * NTHR + tid, NGT = G * NTHR;
    LAS float* sl = (LAS float*)L;
    for (int i = tid; i < 5 * DM; i += NTHR) { const float v = i < 4 * DM ? a.in[1][i] : a.in[3][i - 4 * DM]; sl[i] = v / (1.f + expf(-v)); }
    __syncthreads();
    float* MOD = (float*)(ws + WS_MOD);
#ifdef PROBE_P0_MODREP
    for (int rp_ = 0; rp_ < 2; ++rp_)
#endif
    for (int it = NGW - 1 - gw; it < 2 * 384; it += NGW) {
        const int l = it / 384, cgp = it % 384, colq = lane & 7, ks = lane >> 3, n0 = cgp * 32 + colq * 4;
        const float* wp = a.in[4] + (size_t)l * DM * MODW + n0;
        f32x4 acc[5];
#pragma unroll
        for (int r = 0; r < 5; ++r) acc[r] = (f32x4){0.f, 0.f, 0.f, 0.f};
#pragma unroll 8
        for (int k = ks; k < DM; k += 8) { const f32x4 w4 = __builtin_nontemporal_load((const f32x4*)(wp + (size_t)k * MODW));
#pragma unroll
            for (int r = 0; r < 5; ++r) acc[r] += w4 * sl[r * DM + k]; }
#pragma unroll
        for (int r = 0; r < 5; ++r)
#pragma unroll
            for (int e = 0; e < 4; ++e) { float v = acc[r][e]; v += __shfl_xor(v, 8); v += __shfl_xor(v, 16); v += __shfl_xor(v, 32); acc[r][e] = v; }
        if (ks == 0) { const f32x4 bb = *(const f32x4*)(a.in[5] + (size_t)l * MODW + n0);
#pragma unroll
            for (int r = 0; r < 5; ++r) *(f32x4*)(MOD + (size_t)(l * 5 + r) * MODW + n0) = acc[r] + bb; }
    }
    LAS float* scr = (LAS float*)(L + 40960 + wave * 8448);
    constexpr int I_IN = 32 * 216, I_OUT = 32 * 64, I_GLU = 8 * 32, I_FF1 = 32 * 256, I_FF2 = 128 * 64, I_L = I_IN + I_OUT + I_GLU + I_FF1 + I_FF2;
#ifdef PROBE_P0_TRREP
    for (int rp_ = 0; rp_ < 2; ++rp_)
#endif
    for (int it = gw; it < 2 * I_L; it += NGW) {
        const int l = it / I_L; int r = it % I_L;
        if (r < I_IN) { const int kb = r / 216, nb = r % 216; p0_transpose_item(a.in[8] + (size_t)l * DM * INW, DM, INW, (bf16_t*)(ws + WS_WIN + (size_t)l * 27 * MiB), kb, 32 * nb, 32 * nb, scr, lane); continue; } r -= I_IN;
        if (r < I_OUT) { const int kb = r / 64, nb = r % 64; p0_transpose_item(a.in[9] + (size_t)l * DM * DM, DM, DM, (bf16_t*)(ws + WS_WOUT + (size_t)l * 8 * MiB), kb, 32 * nb, 32 * nb, scr, lane); continue; } r -= I_OUT;
        if (r < I_GLU) { const int kb = r / 32, nb = r % 32, n0 = 32 * nb, orow = ((n0 & 511) >> 7) * 256 + (n0 >> 9) * 128 + (n0 & 127);
            p0_transpose_item(a.in[18] + (size_t)l * 512 * 1024, 512, 1024, (bf16_t*)(ws + WS_WGLU + (size_t)l * 1 * MiB), kb, n0, orow, scr, lane); continue; } r -= I_GLU;
        if (r < I_FF1) { const int kb = r / 256, nb = r % 256; p0_transpose_item(a.in[25] + (size_t)l * DM * DFF, DM, DFF, (bf16_t*)(ws + WS_WFF1 + (size_t)l * 32 * MiB), kb, 32 * nb, 32 * nb, scr, lane); continue; } r -= I_FF1;
        { const int kb = r / 64, nb = r % 64; p0_transpose_item(a.in[26] + (size_t)l * DFF * DM, DFF, DM, (bf16_t*)(ws + WS_WFF2 + (size_t)l * 32 * MiB), kb, 32 * nb, 32 * nb, scr, lane); }
    }
    if (gt < 8192) {
        const int p = gt & 63, idx = gt >> 6;
        const float lre = fminf(a.in[10][idx * 64 + p], -1e-4f), lim = a.in[11][idx * 64 + p], step = expf(a.in[12][idx]);
        const float mag = expf(lre * step), abr = mag * cosf(lim * step), abi = mag * sinf(lim * step);
        const float den = lre * lre + lim * lim, ir = lre / den, ii = -lim / den;
        const float nr = (abr - 1.f) * ir - abi * ii, ni = (abr - 1.f) * ii + abi * ir;
        unsigned char* t = ws + WS_S5T;
        ((float*)(t + S5_ABR))[gt] = abr; ((float*)(t + S5_ABI))[gt] = abi;
        float pr = abr, pi = abi;
#pragma unroll
        for (int s = 0; s < 6; ++s) { const float nr2 = pr * pr - pi * pi, ni2 = 2.f * pr * pi; pr = nr2; pi = ni2; }
        ((float*)(t + S5_A64R))[gt] = pr; ((float*)(t + S5_A64I))[gt] = pi;
        bf16_t* BBT = (bf16_t*)(t + S5_BBT); bf16_t* CT = (bf16_t*)(t + S5_CT);
        for (int m = 0; m < 16; ++m) { const float br = a.in[13][(size_t)(idx * 64 + p) * 16 + m], bi = a.in[14][(size_t)(idx * 64 + p) * 16 + m];
            BBT[(size_t)(idx * 128 + p) * 16 + m] = (bf16_t)f2bf(nr * br - ni * bi); BBT[(size_t)(idx * 128 + 64 + p) * 16 + m] = (bf16_t)f2bf(nr * bi + ni * br); }
        for (int n = 0; n < 16; ++n) { CT[(size_t)(idx * 16 + n) * 128 + 2 * p] = (bf16_t)f2bf(a.in[15][(size_t)(idx * 16 + n) * 64 + p]); CT[(size_t)(idx * 16 + n) * 128 + 2 * p + 1] = (bf16_t)f2bf(-a.in[16][(size_t)(idx * 16 + n) * 64 + p]); }
    }
    float* RT = (float*)(ws + WS_ROPE);
    for (int e = gt; e < SEQ * 64; e += NGT) { const int t = e >> 6, j = e & 63; const float pos = (float)(j < 32 ? (t >> 6) : (t & 63));
        const float inv = powf(10000.f, -(float)(j & 31) / 32.f), ang = pos * inv; RT[2 * e] = cosf(ang); RT[2 * e + 1] = sinf(ang); }
}

__device__ __forceinline__ float wave_sum(float v) {
#pragma unroll
    for (int o = 1; o < 64; o <<= 1) v += __shfl_xor(v, o);
    return v;
}
__device__ __forceinline__ void phase_norm(const float* resL, const float* resC, const float* nw, const float* modl, int si, bf16_t* XN, int M, int lane, int wave) {
    const int gw = blockIdx.x * NWAVES + wave, NGW = gridDim.x * NWAVES;
    for (int row = gw; row < M; row += NGW) {
        const float* src = row < MLAT ? resL + (size_t)row * DM : resC + (size_t)(row - MLAT) * DM;
        const int mr = row < MLAT ? row / SEQ : 4;
        const float* sh = modl + (size_t)mr * MODW + si * DM; const float* sc = sh + DM;
        f32x4 v[8]; float ss = 0.f;
#pragma unroll
        for (int j = 0; j < 8; ++j) { v[j] = __builtin_nontemporal_load((const f32x4*)(src + (j * 64 + lane) * 4)); ss += (v[j][0] * v[j][0] + v[j][1] * v[j][1]) + (v[j][2] * v[j][2] + v[j][3] * v[j][3]); }
        const float rstd = rsqrtf(wave_sum(ss) * (1.f / DM) + EPSN);
#pragma unroll
        for (int j = 0; j < 8; ++j) { const int c = (j * 64 + lane) * 4; const f32x4 w = *(const f32x4*)(nw + c), s1 = *(const f32x4*)(sc + c), s0 = *(const f32x4*)(sh + c);
            f32x4 y = (v[j] * rstd) * w; y = y * (s1 + 1.f) + s0;
            u32x2 o; o.x = pk2(y[0], y[1]); o.y = pk2(y[2], y[3]); *(u32x2*)(XN + (size_t)row * DM + c) = o; }
    }
}
__device__ __forceinline__ void bias_gemv(const float* shiftbase, const bf16_t* Wt, int N, float* out, int ldo, LAS unsigned char* L, int tid, int lane, int wave) {
    LAS float* sh = (LAS float*)L;
    __syncthreads();
#pragma unroll 1
    for (int i = tid; i < 5 * DM; i += NTHR) sh[i] = shiftbase[(size_t)(i >> 11) * MODW + (i & 2047)];
    __syncthreads();
    const int gw = blockIdx.x * NWAVES + wave, NGW = gridDim.x * NWAVES, sub = lane >> 4, l16 = lane & 15;
#pragma unroll 1
    for (int n0 = gw * 4; n0 < N; n0 += NGW * 4) {
        const int n = n0 + sub;
        float s[5] = {0.f, 0.f, 0.f, 0.f, 0.f};
#pragma unroll 4
        for (int q = 0; q < 16; ++q) { const int k = q * 128 + l16 * 8; const u32x4 v = __builtin_nontemporal_load((const u32x4*)(Wt + (size_t)n * DM + k));
            const float w0 = bflo(v.x), w1 = bfhi(v.x), w2 = bflo(v.y), w3 = bfhi(v.y), w4 = bflo(v.z), w5 = bfhi(v.z), w6 = bflo(v.w), w7 = bfhi(v.w);
#pragma unroll
            for (int r = 0; r < 5; ++r) { const f32x4 sa = *(const LAS f32x4*)(sh + r * DM + k), sb = *(const LAS f32x4*)(sh + r * DM + k + 4);
                s[r] += (w0 * sa[0] + w1 * sa[1]) + (w2 * sa[2] + w3 * sa[3]) + (w4 * sb[0] + w5 * sb[1]) + (w6 * sb[2] + w7 * sb[3]); } }
#pragma unroll
        for (int r = 0; r < 5; ++r) { float t = s[r]; t += __shfl_xor(t, 1); t += __shfl_xor(t, 2); t += __shfl_xor(t, 4); t += __shfl_xor(t, 8);
            if (l16 == 0) out[(size_t)r * ldo + n] = t; }
    }
}
__device__ __forceinline__ void phase_final(const float* X, const float* nw, float* out, int lane, int wave) {
    const int gw = blockIdx.x * NWAVES + wave, NGW = gridDim.x * NWAVES;
    for (int row = gw; row < MLAT; row += NGW) {
        const float* src = X + (size_t)row * DM;
        f32x4 v[8]; float ss = 0.f;
#pragma unroll
        for (int j = 0; j < 8; ++j) { v[j] = __builtin_nontemporal_load((const f32x4*)(src + (j * 64 + lane) * 4)); ss += (v[j][0] * v[j][0] + v[j][1] * v[j][1]) + (v[j][2] * v[j][2] + v[j][3] * v[j][3]); }
        const float rstd = rsqrtf(wave_sum(ss) * (1.f / DM) + EPSN);
#pragma unroll
        for (int j = 0; j < 8; ++j) { const int c = (j * 64 + lane) * 4; const f32x4 w = *(const f32x4*)(nw + c); __builtin_nontemporal_store((v[j] * rstd) * w, (f32x4*)(out + (size_t)row * DM + c)); }
    }
}

constexpr int TS = 136;
constexpr int TILE_B = 128 * TS * 2;
constexpr int LA_ARR = 4 * TILE_B;
constexpr int AR_B = 0, AR_G = 256, AR_M = 512, AR_RS = 768, AR_N = 1024, AR_W = 1280, AR_KP = 1536, AR_MISC = 2048;

__device__ __forceinline__ bf16x8 frag_row(const LAS unsigned char* tile, int r0, int ks, int lane) {
    return *(const LAS bf16x8*)(tile + ((r0 + (lane & 15)) * TS + 32 * ks + 8 * (lane >> 4)) * 2);
}
__device__ __forceinline__ bf16x8 frag_tr(const LAS unsigned char* tile, int c0, int ks, int lane) {
    const int g = lane >> 4, q = (lane & 15) >> 2, p = lane & 3;
    const LAS unsigned char* a0 = tile + ((32 * ks + 8 * g + q) * TS + c0 + 4 * p) * 2;
    const s16x4 lo = __builtin_amdgcn_ds_read_tr16_b64_v4i16((LAS s16x4*)a0);
    const s16x4 hi = __builtin_amdgcn_ds_read_tr16_b64_v4i16((LAS s16x4*)(a0 + 4 * TS * 2));
    return (bf16x8){lo[0], lo[1], lo[2], lo[3], hi[0], hi[1], hi[2], hi[3]};
}
__device__ __forceinline__ void tile_copy(LAS unsigned char* tile, const bf16_t* src, int ld, int tid) {
#pragma unroll
    for (int i = 0; i < 4; ++i) { const int id = tid + NTHR * i, row = id >> 4, ch = id & 15;
        const u32x4 v = *(const u32x4*)(src + (size_t)row * ld + ch * 8);
        *(LAS u32x4*)(tile + (row * TS + ch * 8) * 2) = v; }
}
__device__ __forceinline__ void ld_pair(const bf16_t* rowp, int ch, bool rope, int t, const float* RT, float (&lo)[8], float (&hi)[8]) {
    const u32x4 a = *(const u32x4*)(rowp + ch * 8), b = *(const u32x4*)(rowp + 64 + ch * 8);
    lo[0] = bflo(a.x); lo[1] = bfhi(a.x); lo[2] = bflo(a.y); lo[3] = bfhi(a.y); lo[4] = bflo(a.z); lo[5] = bfhi(a.z); lo[6] = bflo(a.w); lo[7] = bfhi(a.w);
    hi[0] = bflo(b.x); hi[1] = bfhi(b.x); hi[2] = bflo(b.y); hi[3] = bfhi(b.y); hi[4] = bflo(b.z); hi[5] = bfhi(b.z); hi[6] = bflo(b.w); hi[7] = bfhi(b.w);
    if (rope) {
        const f32x4* cs = (const f32x4*)(RT + ((size_t)t * 64 + ch * 8) * 2);
#pragma unroll
        for (int q = 0; q < 4; ++q) { const f32x4 v = cs[q];
            { const float x1 = lo[2 * q], x2 = hi[2 * q]; lo[2 * q] = x1 * v[0] - x2 * v[1]; hi[2 * q] = x1 * v[1] + x2 * v[0]; }
            { const float x1 = lo[2 * q + 1], x2 = hi[2 * q + 1]; lo[2 * q + 1] = x1 * v[2] - x2 * v[3]; hi[2 * q + 1] = x1 * v[3] + x2 * v[2]; } }
    }
}
__device__ __forceinline__ void st8(LAS unsigned char* p, const float (&v)[8], float s) {
    u32x4 w; w.x = pk2(v[0] * s, v[1] * s); w.y = pk2(v[2] * s, v[3] * s); w.z = pk2(v[4] * s, v[5] * s); w.w = pk2(v[6] * s, v[7] * s);
    *(LAS u32x4*)p = w;
}
struct GateScan { float b0, b1, g0, g1, cm0, cm1, btot, gmax; int p0, p1; };
__device__ __forceinline__ GateScan gate_scan(int ty, int d, int lane, const float* gates, int rowbase, int h, float lgv, float ibv, float fbv) {
    GateScan r; const int i0 = 2 * lane, i1 = i0 + 1; r.p0 = d ? 127 - i0 : i0; r.p1 = d ? 127 - i1 : i1;
    float lf0 = lgv, lf1 = lgv, ii0 = 0.f, ii1 = 0.f;
    if (ty) { const float* g0p = gates + (size_t)(rowbase + r.p0) * 24 + d * 12 + h; const float* g1p = gates + (size_t)(rowbase + r.p1) * 24 + d * 12 + h;
        ii0 = g0p[0] + ibv; ii1 = g1p[0] + ibv; lf0 = logsigf_(g0p[6] + fbv); lf1 = logsigf_(g1p[6] + fbv); }
    const float s1 = lf0 + lf1; float inc = s1;
#pragma unroll
    for (int o = 1; o < 64; o <<= 1) { const float t = __shfl_up(inc, o); if (lane >= o) inc += t; }
    const float ex = inc - s1;
    r.b0 = ex + lf0; r.b1 = ex + s1; r.btot = __shfl(inc, 63);
    r.g0 = ii0 - r.b0; r.g1 = ii1 - r.b1;
    const float c1 = fmaxf(r.g0, r.g1); float mx = c1;
#pragma unroll
    for (int o = 1; o < 64; o <<= 1) { const float t = __shfl_up(mx, o); if (lane >= o) mx = fmaxf(mx, t); }
    float exm = __shfl_up(mx, 1); if (lane == 0) exm = -3.0e38f;
    r.cm0 = fmaxf(exm, r.g0); r.cm1 = fmaxf(exm, c1); r.gmax = __shfl(mx, 63);
    return r;
}

struct LaCtx { const Args* a; int l; bool last; };

__device__ __forceinline__ void la_phase_c(const Args& a, int l, LAS unsigned char* L, int task, int tid, int lane, int wave) {
    unsigned char* ws = a.ws;
    const int ty = task / 432, rem = task % 432, b = rem / 108, h = (rem % 108) / 18, pb = rem % 18;
    const int rowbase = pb_row(b, pb), colq = (ty ? COL_M : COL_R) + h * 128;
    const bf16_t* Ab = (const bf16_t*)(ws + WS_A);
    LAS float* AR = (LAS float*)(L + LA_ARR);
    const bool rope = (ty == 0 && pb >= 2);
    const float scale = 0.08838834764831845f;
    const int seq0 = ((ty * 4 + b) * 6 + h) * 2;
    if (wave < 2) {
        const int d = wave;
        const float lgv = logsigf_(a.in[20][(l * 2 + d) * 6 + h]), ibv = a.in[22][(l * 2 + d) * 6 + h], fbv = a.in[23][(l * 2 + d) * 6 + h];
        const GateScan s = gate_scan(ty, d, lane, (const float*)(ws + WS_GATES), rowbase, h, lgv, ibv, fbv);
        const float mloc = ty ? s.btot + s.gmax : 0.f;
        AR[AR_W + d * 128 + s.p0] = expf(s.btot + s.g0 - mloc) * scale; AR[AR_W + d * 128 + s.p1] = expf(s.btot + s.g1 - mloc) * scale;
        if (lane == 0) { float* SC = (float*)(ws + WS_SMALL + SM_SC) + (size_t)((seq0 + d) * NPB + pb) * 2; SC[0] = s.btot; SC[1] = mloc; }
        { float* GS = (float*)(ws + WS_GS) + (size_t)((seq0 + d) * NPB + pb) * 384;
          GS[s.p0] = s.b0; GS[s.p1] = s.b1; GS[128 + s.p0] = s.g0; GS[128 + s.p1] = s.g1; GS[256 + s.p0] = s.cm0; GS[256 + s.p1] = s.cm1; }
    }
    const float* RT = (const float*)(ws + WS_ROPE);
    float klo[2][8], khi[2][8];
#pragma unroll
    for (int i = 0; i < 2; ++i) { const int id = tid + NTHR * i, row = id >> 3, ch = id & 7;
        ld_pair(Ab + (size_t)(rowbase + row) * AW + colq + 768, ch, rope, (pb - 2) * 128 + row, RT, klo[i], khi[i]); }
    tile_copy(L + 2 * TILE_B, Ab + (size_t)rowbase * AW + colq + 1536, AW, tid);
    __syncthreads();
#pragma unroll
    for (int i = 0; i < 2; ++i) { const int id = tid + NTHR * i, row = id >> 3, ch = id & 7;
        const float w0 = AR[AR_W + row], w1 = AR[AR_W + 128 + row];
        st8(L + (row * TS + ch * 8) * 2, klo[i], w0); st8(L + (row * TS + 64 + ch * 8) * 2, khi[i], w0);
        st8(L + TILE_B + (row * TS + ch * 8) * 2, klo[i], w1); st8(L + TILE_B + (row * TS + 64 + ch * 8) * 2, khi[i], w1); }
    __syncthreads();
    const int c = lane & 15, g = lane >> 4;
    bf16_t* KV = (bf16_t*)(ws + WS_KV);
#pragma unroll
    for (int d = 0; d < 2; ++d) {
        f32x4 kv[8];
#pragma unroll
        for (int jt = 0; jt < 8; ++jt) kv[jt] = (f32x4){0.f, 0.f, 0.f, 0.f};
#pragma unroll
        for (int ks = 0; ks < 4; ++ks) { const bf16x8 bv = frag_tr(L + 2 * TILE_B, 16 * wave, ks, lane);
#pragma unroll
            for (int jt = 0; jt < 8; ++jt) { const bf16x8 ak = frag_tr(L + d * TILE_B, 16 * jt, ks, lane); kv[jt] = mfma16(ak, bv, kv[jt]); } }
        bf16_t* dst = KV + ((size_t)((seq0 + d) * NPB + pb) * 128 + 16 * wave + c) * 128 + 4 * g;
#pragma unroll
        for (int jt = 0; jt < 8; ++jt) { u32x2 o; o.x = pk2(kv[jt][0], kv[jt][1]); o.y = pk2(kv[jt][2], kv[jt][3]); *(u32x2*)(dst + 16 * jt) = o; }
    }
    if (ty) {
        const int dk = tid & 127, d = (tid >> 7) & 1, half = tid >> 8; float s = 0.f;
        const LAS bf16_t* T = (const LAS bf16_t*)(L + d * TILE_B);
        for (int p = half * 64; p < half * 64 + 64; ++p) s += bf1(T[p * TS + dk]);
        AR[AR_KP + (half * 2 + d) * 128 + dk] = s;
    }
    __syncthreads();
    if (ty && tid < 256) { const int dk = tid & 127, d = tid >> 7;
        ((float*)(ws + WS_SMALL + SM_KN))[(size_t)((seq0 + d) * NPB + pb) * 128 + dk] = AR[AR_KP + d * 128 + dk] + AR[AR_KP + (2 + d) * 128 + dk]; }
    __syncthreads();
}

__device__ __forceinline__ void la_phase_d(const Args& a, int tid) {
    unsigned char* ws = a.ws;
    const int gt = blockIdx.x * NTHR + tid, NGT = gridDim.x * NTHR;
    const float* SC = (const float*)(ws + WS_SMALL + SM_SC); float* MP = (float*)(ws + WS_SMALL + SM_MPREV);
    const bf16_t* KV = (const bf16_t*)(ws + WS_KV); bf16_t* CB = (bf16_t*)(ws + WS_CB);
#pragma unroll 1
    for (int it = gt; it < 96 * 4096; it += NGT) {
        const int seq = it >> 12, e4 = it & 4095, d = seq & 1, ty = seq >= 48;
        u32x2 kv[NPB]; float be[NPB], ml[NPB];
#pragma unroll
        for (int k = 0; k < NPB; ++k) { const int pb = seq_pb(d, k); const size_t o = (size_t)(seq * NPB + pb);
            kv[k] = __builtin_nontemporal_load((const u32x2*)(KV + o * 16384 + e4 * 4)); be[k] = SC[o * 2]; ml[k] = SC[o * 2 + 1]; }
        float c0 = 0.f, c1 = 0.f, c2 = 0.f, c3 = 0.f, m = 0.f;
#pragma unroll
        for (int k = 0; k < NPB; ++k) { const int pb = seq_pb(d, k); const size_t o = (size_t)(seq * NPB + pb);
            u32x2 w; w.x = pk2(c0, c1); w.y = pk2(c2, c3); *(u32x2*)(CB + o * 16384 + e4 * 4) = w;
            if (e4 == 0) MP[o] = m;
            const float mn = ty ? fmaxf(be[k] + m, ml[k]) : 0.f, al = __expf(be[k] + m - mn), bt = __expf(ml[k] - mn);
            c0 = al * c0 + bt * bflo(kv[k].x); c1 = al * c1 + bt * bfhi(kv[k].x); c2 = al * c2 + bt * bflo(kv[k].y); c3 = al * c3 + bt * bfhi(kv[k].y); m = mn; }
    }
    const float* KN = (const float*)(ws + WS_SMALL + SM_KN); float* NBF = (float*)(ws + WS_SMALL + SM_NBEF);
    for (int it = gt; it < 48 * 128; it += NGT) {
        const int seq = 48 + (it >> 7), dk = it & 127, d = seq & 1;
        float kn[NPB], be[NPB], ml[NPB];
#pragma unroll
        for (int k = 0; k < NPB; ++k) { const int pb = seq_pb(d, k); const size_t o = (size_t)(seq * NPB + pb); kn[k] = KN[o * 128 + dk]; be[k] = SC[o * 2]; ml[k] = SC[o * 2 + 1]; }
        float n = 0.f, m = 0.f;
#pragma unroll
        for (int k = 0; k < NPB; ++k) { const int pb = seq_pb(d, k); const size_t o = (size_t)(seq * NPB + pb);
            NBF[o * 128 + dk] = n;
            const float mn = fmaxf(be[k] + m, ml[k]), al = __expf(be[k] + m - mn), bt = __expf(ml[k] - mn);
            n = al * n + bt * kn[k]; m = mn; }
    }
}

__device__ __forceinline__ void unpack8(const u32x4 a, float (&v)[8]) { v[0] = bflo(a.x); v[1] = bfhi(a.x); v[2] = bflo(a.y); v[3] = bfhi(a.y); v[4] = bflo(a.z); v[5] = bfhi(a.z); v[6] = bflo(a.w); v[7] = bfhi(a.w); }
__device__ __forceinline__ void rope8(const f32x4 (&cs)[4], float (&lo)[8], float (&hi)[8]) {
#pragma unroll
    for (int q = 0; q < 4; ++q) { const f32x4 v = cs[q];
        { const float x1 = lo[2 * q], x2 = hi[2 * q]; lo[2 * q] = x1 * v[0] - x2 * v[1]; hi[2 * q] = x1 * v[1] + x2 * v[0]; }
        { const float x1 = lo[2 * q + 1], x2 = hi[2 * q + 1]; lo[2 * q + 1] = x1 * v[2] - x2 * v[3]; hi[2 * q + 1] = x1 * v[3] + x2 * v[2]; } }
}
__device__ __forceinline__ void la_phase_e(const Args& a, int l, LAS unsigned char* L, int task, int tid, int lane, int wave) {
    unsigned char* ws = a.ws;
    const int ty = task / 432, rem = task % 432, b = rem / 108, h = (rem % 108) / 18, pb = rem % 18;
    const int rowbase = pb_row(b, pb), colq = (ty ? COL_M : COL_R) + h * 128;
    const bf16_t* Ab = (const bf16_t*)(ws + WS_A);
    LAS float* AR = (LAS float*)(L + LA_ARR);
    const bool rope = (ty == 0 && pb >= 2);
    const float scale = 0.08838834764831845f;
    const int seq0 = ((ty * 4 + b) * 6 + h) * 2;
    const float* MP = (const float*)(ws + WS_SMALL + SM_MPREV);
    const float mp0 = ty ? MP[(size_t)(seq0 + 0) * NPB + pb] : 0.f, mp1 = ty ? MP[(size_t)(seq0 + 1) * NPB + pb] : 0.f;
    const float* RT = (const float*)(ws + WS_ROPE);
    const bf16_t* CB = (const bf16_t*)(ws + WS_CB);
    const int c = lane & 15, g = lane >> 4, p = 16 * wave + c;
    u32x4 ct1[4];
    const bf16_t* gp = Ab + (size_t)(rowbase + p) * AW + colq + 2304;
    u32x2 gvr[8];
#ifdef PROBE_LAE_LOADREP
#pragma unroll 1
    for (int rp_ = 0; rp_ < 2; ++rp_) {
#endif
    if (wave < 4) {
        const int d = tid >> 7, pp = tid & 127;
        const float* GS = (const float*)(ws + WS_GS) + (size_t)((seq0 + d) * NPB + pb) * 384;
        const float bb = GS[pp], gg = GS[128 + pp], cm = GS[256 + pp], mp = d ? mp1 : mp0;
        AR[AR_B + d * 128 + pp] = bb; AR[AR_G + d * 128 + pp] = gg; AR[AR_M + d * 128 + pp] = ty ? fmaxf(mp, cm) : -bb;
    }
    if (wave >= 4 && ty) {
        const int i = tid - 256, d = i >> 7, dk = i & 127;
        AR[AR_N + d * 128 + dk] = ((const float*)(ws + WS_SMALL + SM_NBEF))[(size_t)((seq0 + d) * NPB + pb) * 128 + dk];
    }
    if (wave >= 6) { const int i = tid - 384; AR[AR_W + i] = ((ty ? a.in[24] : a.in[21]) + (size_t)l * 768 + h * 128)[i]; }
#pragma unroll
    for (int i = 0; i < 2; ++i) { const int id = tid + NTHR * i, row = id >> 3, ch = id & 7; float lo[8], hi[8];
        const bf16_t* rp = Ab + (size_t)(rowbase + row) * AW + colq + ch * 8;
        const u32x4 qa = *(const u32x4*)rp, qb = *(const u32x4*)(rp + 64), ka = *(const u32x4*)(rp + 768), kb = *(const u32x4*)(rp + 768 + 64);
        f32x4 cs[4];
        if (rope) { const f32x4* cp = (const f32x4*)(RT + ((size_t)((pb - 2) * 128 + row) * 64 + ch * 8) * 2); cs[0] = cp[0]; cs[1] = cp[1]; cs[2] = cp[2]; cs[3] = cp[3]; }
        unpack8(qa, lo); unpack8(qb, hi); if (rope) rope8(cs, lo, hi);
        st8(L + (row * TS + ch * 8) * 2, lo, 1.f); st8(L + (row * TS + 64 + ch * 8) * 2, hi, 1.f);
        unpack8(ka, lo); unpack8(kb, hi); if (rope) rope8(cs, lo, hi);
        st8(L + TILE_B + (row * TS + ch * 8) * 2, lo, 1.f); st8(L + TILE_B + (row * TS + 64 + ch * 8) * 2, hi, 1.f); }
    __syncthreads();
#ifdef PROBE_LAE_LOADREP
    }
#endif
    u32x4 vreg[4], c0reg[4];
#pragma unroll
    for (int i = 0; i < 4; ++i) { const int id = tid + NTHR * i, row = id >> 4, ch = id & 15;
        vreg[i] = *(const u32x4*)(Ab + (size_t)(rowbase + row) * AW + colq + 1536 + ch * 8);
        c0reg[i] = *(const u32x4*)(CB + (size_t)((seq0 + 0) * NPB + pb) * 16384 + (size_t)row * 128 + ch * 8); }
    f32x4 s[8];
#pragma unroll
    for (int jt = 0; jt < 8; ++jt) s[jt] = (f32x4){0.f, 0.f, 0.f, 0.f};
#pragma unroll
    for (int ks = 0; ks < 4; ++ks) { const bf16x8 bq = frag_row(L, 16 * wave, ks, lane);
#pragma unroll
        for (int jt = 0; jt < 8; ++jt) { const bf16x8 ak = frag_row(L + TILE_B, 16 * jt, ks, lane); s[jt] = mfma16(ak, bq, s[jt]); } }
    float qn0 = 0.f, qn1 = 0.f;
    if (ty) {
        const LAS bf16_t* qr = (const LAS bf16_t*)L + p * TS + 32 * g;
#pragma unroll 8
        for (int j = 0; j < 32; ++j) { const float q = bf1(qr[j]); qn0 += q * AR[AR_N + 32 * g + j]; qn1 += q * AR[AR_N + 128 + 32 * g + j]; }
        qn0 += __shfl_xor(qn0, 16); qn0 += __shfl_xor(qn0, 32); qn1 += __shfl_xor(qn1, 16); qn1 += __shfl_xor(qn1, 32);
    }
    const float M0 = AR[AR_M + p], M1 = AR[AR_M + 128 + p];
    f32x4 P1[8]; float rs0 = 0.f, rs1 = 0.f;
#pragma unroll
    for (int jt = 0; jt < 8; ++jt) {
        const f32x4 g0v = *(const LAS f32x4*)(AR + AR_G + 16 * jt + 4 * g), g1v = *(const LAS f32x4*)(AR + AR_G + 128 + 16 * jt + 4 * g);
#pragma unroll
        for (int e = 0; e < 4; ++e) { const int pp = 16 * jt + 4 * g + e; const float sv = s[jt][e] * scale;
            const float w0 = pp <= p ? __expf(g0v[e] - M0) : 0.f, w1 = pp >= p ? __expf(g1v[e] - M1) : 0.f;
            const float x0 = sv * w0, x1 = sv * w1; s[jt][e] = x0; P1[jt][e] = x1; rs0 += x0; rs1 += x1; }
    }
    rs0 += __shfl_xor(rs0, 16); rs0 += __shfl_xor(rs0, 32); rs1 += __shfl_xor(rs1, 16); rs1 += __shfl_xor(rs1, 32);
    float idn0 = 1.f, idn1 = 1.f, a0 = __expf(mp0 - M0), a1 = __expf(mp1 - M1);
    if (ty) {
        const float den0 = rs0 + a0 * qn0, den1 = rs1 + a1 * qn1;
        idn0 = 1.f / fmaxf(fabsf(den0), __expf(-(AR[AR_B + p] + M0))); idn1 = 1.f / fmaxf(fabsf(den1), __expf(-(AR[AR_B + 128 + p] + M1)));
    }
#pragma unroll
    for (int i = 0; i < 4; ++i) { const int id = tid + NTHR * i; const int off = ((id >> 4) * TS + (id & 15) * 8) * 2;
        *(LAS u32x4*)(L + 2 * TILE_B + off) = vreg[i]; *(LAS u32x4*)(L + 3 * TILE_B + off) = c0reg[i]; }
    __syncthreads();
#pragma unroll
    for (int jt = 0; jt < 8; ++jt) { const f32x4 v = s[jt] * idn0 + P1[jt] * idn1; u32x2 o; o.x = pk2(v[0], v[1]); o.y = pk2(v[2], v[3]);
        *(LAS u32x2*)(L + TILE_B + (p * TS + 16 * jt + 4 * g) * 2) = o; }
    if (g == 0) { AR[AR_RS + p] = a0 * idn0; AR[AR_RS + 128 + p] = a1 * idn1; }
    __syncthreads();
#pragma unroll
    for (int i = 0; i < 4; ++i) { const int id = tid + NTHR * i; ct1[i] = *(const u32x4*)(CB + (size_t)((seq0 + 1) * NPB + pb) * 16384 + (size_t)(id >> 4) * 128 + (id & 15) * 8); }
#pragma unroll
    for (int jt = 0; jt < 8; ++jt) gvr[jt] = *(const u32x2*)(gp + 16 * jt + 4 * g);
    f32x4 o[8];
#pragma unroll
    for (int jt = 0; jt < 8; ++jt) o[jt] = (f32x4){0.f, 0.f, 0.f, 0.f};
#pragma unroll
    for (int ks = 0; ks < 4; ++ks) { const bf16x8 bs = frag_row(L + TILE_B, 16 * wave, ks, lane);
#pragma unroll
        for (int jt = 0; jt < 8; ++jt) { const bf16x8 av = frag_tr(L + 2 * TILE_B, 16 * jt, ks, lane); o[jt] = mfma16(av, bs, o[jt]); } }
    __syncthreads();
#pragma unroll
    for (int d = 0; d < 2; ++d) {
        if (d == 1) {
#pragma unroll
            for (int i = 0; i < 4; ++i) { const int id = tid + NTHR * i; *(LAS u32x4*)(L + 2 * TILE_B + ((id >> 4) * TS + (id & 15) * 8) * 2) = ct1[i]; } }
        { const int r = 16 * wave + (lane >> 2), cc = (lane & 3) * 32; const float rsv = AR[AR_RS + d * 128 + r];
#pragma unroll
            for (int q = 0; q < 4; ++q) { const u32x4 v = *(const LAS u32x4*)(L + (r * TS + cc + 8 * q) * 2);
                u32x4 w; w.x = pk2(bflo(v.x) * rsv, bfhi(v.x) * rsv); w.y = pk2(bflo(v.y) * rsv, bfhi(v.y) * rsv); w.z = pk2(bflo(v.z) * rsv, bfhi(v.z) * rsv); w.w = pk2(bflo(v.w) * rsv, bfhi(v.w) * rsv);
                *(LAS u32x4*)(L + TILE_B + (r * TS + cc + 8 * q) * 2) = w; } }
        __syncthreads();
        const LAS unsigned char* CT = L + (d ? 2 : 3) * TILE_B;
#pragma unroll
        for (int ks = 0; ks < 4; ++ks) { const bf16x8 bq = frag_row(L + TILE_B, 16 * wave, ks, lane);
#pragma unroll
            for (int jt = 0; jt < 8; ++jt) { const bf16x8 ac = frag_row(CT, 16 * jt, ks, lane); o[jt] = mfma16(ac, bq, o[jt]); } }
        __syncthreads();
    }
    float sum = 0.f;
#pragma unroll
    for (int jt = 0; jt < 8; ++jt) sum += (o[jt][0] + o[jt][1]) + (o[jt][2] + o[jt][3]);
    sum += __shfl_xor(sum, 16); sum += __shfl_xor(sum, 32);
    const float mean = ty ? 0.f : sum * (1.f / 128.f);
    float sq = 0.f;
#pragma unroll
    for (int jt = 0; jt < 8; ++jt) { o[jt] = o[jt] - mean; sq += (o[jt][0] * o[jt][0] + o[jt][1] * o[jt][1]) + (o[jt][2] * o[jt][2] + o[jt][3] * o[jt][3]); }
    sq += __shfl_xor(sq, 16); sq += __shfl_xor(sq, 32);
    const float rstd = rsqrtf(sq * (1.f / 128.f) + EPSN);
    bf16_t* yp = (bf16_t*)(ws + WS_Y) + (size_t)(rowbase + p) * DM + 512 + ty * 768 + h * 128;
#pragma unroll
    for (int jt = 0; jt < 8; ++jt) { const int v0 = 16 * jt + 4 * g; const u32x2 gv = gvr[jt]; const f32x4 w = *(const LAS f32x4*)(AR + AR_W + v0);
        float gt4[4] = {bflo(gv.x), bfhi(gv.x), bflo(gv.y), bfhi(gv.y)}; float y[4];
#pragma unroll
        for (int e = 0; e < 4; ++e) { const float sg = sigmoidf_(gt4[e]); const float act = ty ? sg : gt4[e] * sg; y[e] = o[jt][e] * rstd * w[e] * act; }
        u32x2 ov; ov.x = pk2(y[0], y[1]); ov.y = pk2(y[2], y[3]); *(u32x2*)(yp + v0) = ov; }
}

constexpr int S5_WLDS = 12800;
template <bool FULL>
__device__ __forceinline__ void s5_dir(const Args& a, int l, int b, int g, int sc, int d, LAS unsigned char* W, int lane, const bf16x8 (&afr)[4], f32x4 (&yacc)[4]) {
    unsigned char* ws = a.ws; const unsigned char* T = ws + WS_S5T;
    const int idx = (l * 2 + d) * 32 + g, c = lane & 15, q = lane >> 4;
    LAS float* BU = (LAS float*)W; LAS bf16_t* XS = (LAS bf16_t*)(W + 8448);
    const float abr = ((const float*)(T + S5_ABR))[idx * 64 + lane], abi = ((const float*)(T + S5_ABI))[idx * 64 + lane];
    bf16x8 bfr[8];
#pragma unroll
    for (int ct = 0; ct < 8; ++ct) { bfr[ct] = (bf16x8){0, 0, 0, 0, 0, 0, 0, 0};
        if (q < 2) bfr[ct] = *(const bf16x8*)((const bf16_t*)(T + S5_BBT) + (size_t)(idx * 128 + 16 * ct + c) * 16 + 8 * q); }
    bf16x8 cfr[4];
    if (FULL) {
#pragma unroll
        for (int ks = 0; ks < 4; ++ks) cfr[ks] = *(const bf16x8*)((const bf16_t*)(T + S5_CT) + (size_t)(idx * 16 + c) * 128 + 32 * ks + 8 * q);
    }
    float xr = 0.f, xi = 0.f;
    if (FULL) { const float* XI = (const float*)(ws + WS_XIN) + (size_t)(((b * 32 + g) * 2 + d) * NSC + sc) * 128; xr = XI[lane]; xi = XI[64 + lane]; }
#pragma unroll
    for (int sub = 0; sub < 4; ++sub) {
        const int sb = d ? 3 - sub : sub;
        const bf16x8 af = afr[sb];
#pragma unroll
        for (int ct = 0; ct < 8; ++ct) { const f32x4 r = mfma16(af, bfr[ct], (f32x4){0.f, 0.f, 0.f, 0.f});
#pragma unroll
            for (int j = 0; j < 4; ++j) BU[(4 * q + j) * 132 + 2 * (16 * (ct & 3) + c) + (ct >> 2)] = r[j]; }
        asm volatile("s_waitcnt lgkmcnt(0)" ::: "memory");
#pragma unroll
        for (int i = 0; i < 16; ++i) { const int t = d ? 15 - i : i;
            const hwf32x2_t bu = *(const LAS hwf32x2_t*)(BU + t * 132 + 2 * lane); const float re = bu[0], im = bu[1];
            const float nr = abr * xr - abi * xi + re, ni = abr * xi + abi * xr + im; xr = nr; xi = ni;
            if (FULL) *(LAS unsigned*)(XS + t * 136 + 2 * lane) = pk2(xr, xi); }
        asm volatile("s_waitcnt lgkmcnt(0)" ::: "memory");
        if (FULL) {
#pragma unroll
            for (int ks = 0; ks < 4; ++ks) { const bf16x8 xa = *(const LAS bf16x8*)(XS + c * 136 + 32 * ks + 8 * q); yacc[sb] = mfma16(xa, cfr[ks], yacc[sb]); }
            asm volatile("s_waitcnt lgkmcnt(0)" ::: "memory");
        }
    }
    if (!FULL) { float* ES = (float*)(ws + WS_ES) + (size_t)(((b * 32 + g) * 2 + d) * NSC + sc) * 128; ES[lane] = xr; ES[64 + lane] = xi; }
}
__device__ __forceinline__ void s5_load_af(const Args& a, int b, int g, int sc, int lane, bf16x8 (&afr)[4]) {
    const int c = lane & 15, q = lane >> 4, rowbase = sc_row(b, sc); const bf16_t* Ab = (const bf16_t*)(a.ws + WS_A);
#pragma unroll
    for (int sb = 0; sb < 4; ++sb) { afr[sb] = (bf16x8){0, 0, 0, 0, 0, 0, 0, 0};
        if (q < 2) afr[sb] = *(const bf16x8*)(Ab + (size_t)(rowbase + 16 * sb + c) * AW + g * 16 + 8 * q); }
}
__device__ __forceinline__ float gelu_tanh(float y) { const float u = 0.7978845608028654f * (y + 0.044715f * y * y * y); const float e = __expf(2.f * u); const float t = 1.f - 2.f / (e + 1.f); return 0.5f * y * (1.f + t); }
__device__ __forceinline__ void s5_phase_c(const Args& a, int l, LAS unsigned char* L, int wt, int lane, int wave) {
    const int d = wt & 1, r = wt >> 1, sc = r % NSC, g = (r / NSC) & 31, b = r / (NSC * 32);
    f32x4 dummy[4]; bf16x8 afr[4]; s5_load_af(a, b, g, sc, lane, afr);
    if (d) s5_dir<false>(a, l, b, g, sc, 1, L + wave * S5_WLDS, lane, afr, dummy); else s5_dir<false>(a, l, b, g, sc, 0, L + wave * S5_WLDS, lane, afr, dummy);
}
__device__ __forceinline__ void s5_phase_e(const Args& a, int l, bool last, LAS unsigned char* L, int wt, int lane, int wave) {
    const int sc = wt % NSC, g = (wt / NSC) & 31, b = wt / (NSC * 32);
    if (last && sc < 4) return;
    f32x4 yacc[4];
#pragma unroll
    for (int i = 0; i < 4; ++i) yacc[i] = (f32x4){0.f, 0.f, 0.f, 0.f};
    const int c = lane & 15, q = lane >> 4, rowbase = sc_row(b, sc);
    const bf16_t* Ab = (const bf16_t*)(a.ws + WS_A); bf16_t* G = (bf16_t*)(a.ws + WS_G);
    bf16x8 afr[4]; s5_load_af(a, b, g, sc, lane, afr);
    bf16_t uu[16];
#pragma unroll
    for (int sb = 0; sb < 4; ++sb)
#pragma unroll
        for (int j = 0; j < 4; ++j) uu[sb * 4 + j] = Ab[(size_t)(rowbase + 16 * sb + 4 * q + j) * AW + g * 16 + c];
    const float dsk = a.in[17][(size_t)l * 512 + g * 16 + c];
    s5_dir<true>(a, l, b, g, sc, 0, L + wave * S5_WLDS, lane, afr, yacc);
    s5_dir<true>(a, l, b, g, sc, 1, L + wave * S5_WLDS, lane, afr, yacc);
#pragma unroll
    for (int sb = 0; sb < 4; ++sb)
#pragma unroll
        for (int j = 0; j < 4; ++j) { const int row = rowbase + 16 * sb + 4 * q + j;
            const float y = yacc[sb][j] + dsk * bf1(uu[sb * 4 + j]);
            G[(size_t)row * 512 + g * 16 + c] = (bf16_t)(pk2(gelu_tanh(y), 0.f) & 0xffffu); }
}
__device__ __forceinline__ void s5_phase_d(const Args& a, int l, int tid) {
    unsigned char* ws = a.ws; const unsigned char* T = ws + WS_S5T;
    if (tid >= 64) return;
    for (int sq = blockIdx.x; sq < 256; sq += gridDim.x) {
        const int p = tid, d = sq & 1, g = (sq >> 1) & 31, idx = (l * 2 + d) * 32 + g;
        const float ar = ((const float*)(T + S5_A64R))[idx * 64 + p], ai = ((const float*)(T + S5_A64I))[idx * 64 + p];
        const float* ES = (const float*)(ws + WS_ES) + (size_t)sq * NSC * 128; float* XI = (float*)(ws + WS_XIN) + (size_t)sq * NSC * 128;
        float er[NSC], ei[NSC];
#pragma unroll
        for (int k = 0; k < NSC; ++k) { const int sc = seq_sc(d, k); er[k] = ES[sc * 128 + p]; ei[k] = ES[sc * 128 + 64 + p]; }
        float xr = 0.f, xi = 0.f;
#pragma unroll
        for (int k = 0; k < NSC; ++k) { const int sc = seq_sc(d, k);
            XI[sc * 128 + p] = xr; XI[sc * 128 + 64 + p] = xi;
            const float nr = ar * xr - ai * xi + er[k], ni = ar * xi + ai * xr + ei[k]; xr = nr; xi = ni; }
    }
}

#define XB_TMO      128
#define XB_XCNT(j)  (256  + 64 * (j))
#define XB_XSUB(j)  (1280 + 64 * (j))
#define XB_XGEN(j)  (2304 + 64 * (j))
#define XB_TOP      3328
#define XB_TOPGEN   3392
#define XCD_BAR_WORDS 3456
#define XB_SPIN_CAP (1u << 18)

__device__ __forceinline__ unsigned xb_ld(unsigned* p)              { return __hip_atomic_load(p, __ATOMIC_RELAXED, __HIP_MEMORY_SCOPE_AGENT); }
__device__ __forceinline__ unsigned xb_add(unsigned* p, unsigned v) { return __hip_atomic_fetch_add(p, v, __ATOMIC_RELAXED, __HIP_MEMORY_SCOPE_AGENT); }
__device__ __forceinline__ unsigned xb_xcc_id() { return (unsigned)__builtin_amdgcn_s_getreg((3 << 11) | 20) & 0xFu; }
#define XB_SPIN(cond, bar) do { unsigned _sp = 0; while (cond) { __builtin_amdgcn_s_sleep(1); \
    if ((++_sp & 255u) == 0u) { if (xb_ld(&(bar)[XB_TMO])) break; if (_sp > XB_SPIN_CAP) { atomicAdd(&(bar)[XB_TMO], 1u); break; } } } } while (0)

struct XcdBarrier {
    unsigned* bar; unsigned x;
    volatile LAS unsigned* st;
};

__device__ __forceinline__ XcdBarrier xcd_barrier_post(unsigned* bar, volatile LAS unsigned* st) {
    XcdBarrier b; b.bar = bar; b.x = xb_xcc_id(); b.st = st;
    if (threadIdx.x == 0) (void)xb_add(&bar[XB_XCNT(b.x)], 1u);
    return b;
}
__device__ __forceinline__ void xcd_barrier_complete(unsigned* bar, unsigned x, unsigned& nloc, unsigned& nx) {
    const unsigned G = gridDim.x * gridDim.y * gridDim.z;
    unsigned sum, cnt, mine, sp = 0u;
    for (;;) {
        sum = 0u; cnt = 0u; mine = 0u;
#pragma unroll
        for (unsigned j = 0; j < 16; ++j) { const unsigned c = xb_ld(&bar[XB_XCNT(j)]); sum += c; cnt += (c > 0u) ? 1u : 0u; mine = (j == x) ? c : mine; }
        if (sum == G) break;
        __builtin_amdgcn_s_sleep(1);
        if ((++sp & 255u) == 0u) { if (xb_ld(&bar[XB_TMO])) break; if (sp > XB_SPIN_CAP) { atomicAdd(&bar[XB_TMO], 1u); break; } }
    }
    nloc = mine > 0u ? mine : 1u; nx = cnt > 0u ? cnt : 1u;
}

__device__ __forceinline__ void xcd_barrier(const XcdBarrier& b) {
    asm volatile("s_waitcnt vmcnt(0)" ::: "memory");
    __syncthreads();
    if (threadIdx.x == 0) {
        unsigned* bar = b.bar;
        __builtin_amdgcn_s_waitcnt(0);
        unsigned nloc = b.st[0], nx = b.st[1];
        if (nloc == 0u) { xcd_barrier_complete(bar, b.x, nloc, nx); b.st[0] = nloc; b.st[1] = nx; }
        const unsigned old = xb_add(&bar[XB_XSUB(b.x)], 1u);
        const unsigned gen = old / nloc;
        if (old + 1u == (gen + 1u) * nloc) {
            __builtin_amdgcn_fence(__ATOMIC_RELEASE, "agent");
            asm volatile("s_waitcnt vmcnt(0)" ::: "memory");
            const unsigned og = xb_add(&bar[XB_TOP], 1u);
            const unsigned tg = og / nx;
            if (og + 1u == (tg + 1u) * nx) xb_add(&bar[XB_TOPGEN], 1u);
            else XB_SPIN(xb_ld(&bar[XB_TOPGEN]) == tg, bar);
            __builtin_amdgcn_fence(__ATOMIC_ACQUIRE, "agent");
            xb_add(&bar[XB_XGEN(b.x)], 1u);
            asm volatile("s_waitcnt vmcnt(0)" ::: "memory");
        } else {
            XB_SPIN(xb_ld(&bar[XB_XGEN(b.x)]) == gen, bar);
            __builtin_amdgcn_fence(__ATOMIC_ACQUIRE, "agent");
            asm volatile("s_waitcnt vmcnt(0)" ::: "memory");
        }
    }
    __syncthreads();
}

constexpr int PH_L0 = 1, PH_PER_L = 10, PH_FINAL = 21, N_PHASES = 22;

struct SliceOrder {
    pg8::StaticOrder base; int full, R, S, Kr, c;
    __device__ bool next(int i, pg8::Unit& u) const { if (i != 0) return false; const int t = c / S; if (t >= R) return false; base.map(full + t, u); u.k0 = (c % S) * Kr; return true; }
    __device__ __forceinline__ void a_ready(const pg8::Unit&) const {}
    __device__ __forceinline__ void done(const pg8::Unit&) const {}
};
template <class Epi>
__device__ __forceinline__ void run_gemm(LAS unsigned char* L, const bf16_t* A, const bf16_t* Bt, int M, int N, int K, const Epi& E) {
    pg8::Gemm g{A, Bt, M, N, K, K}; pg8::StaticOrder S; S.init(M, N, (int)gridDim.x, (int)blockIdx.x);
#ifndef NO_GEMM
    pg8::gemm_phase<Epi, pg8::StaticOrder, true, true>((PG8_LAS unsigned char*)L, g, S, E);
#endif
}
struct EpiPart {
    static constexpr bool PERM = true, AFTER_DRAIN = false;
    float* P;
    __device__ __forceinline__ void operator()(const f32x4 (&acc)[2][2][4][2], const pg8::Unit& u, int wr, int wc, int fr, int fq) const {
        const int r0 = wr * 64 + fr, c0 = wc * 32 + 8 * fq;
#pragma unroll
        for (int ai = 0; ai < 2; ++ai)
#pragma unroll
            for (int m = 0; m < 4; ++m) { float* dst = P + (size_t)(r0 + ai * 128 + m * 16) * 256 + c0;
#pragma unroll
                for (int bj = 0; bj < 2; ++bj)
#pragma unroll
                    for (int n = 0; n < 2; ++n) *(f32x4*)(dst + bj * 128 + 4 * n) = acc[ai][bj][m][n]; }
    }
};
__device__ __forceinline__ void run_gemm_res(LAS unsigned char* L, const bf16_t* A, const bf16_t* Bt, int M, int N, int K, const EpiRes& E, float* PART, const XcdBarrier& xbar) {
    const int G = (int)gridDim.x, nwg = (M / 256) * (N / 256), full = (nwg / G) * G, R = nwg - full;
    int S = R > 0 ? G / R : 0; while (S > 1 && (K % (S * 128) != 0 || K / S < 256 || (256 % S) != 0)) --S;
    pg8::StaticOrder So; So.init(M, N, G, (int)blockIdx.x);
    if (S < 2 || full == 0) { pg8::Gemm g{A, Bt, M, N, K, K}; pg8::gemm_phase<EpiRes, pg8::StaticOrder, true, true>((PG8_LAS unsigned char*)L, g, So, E); return; }
    So.limit = full;
    { pg8::Gemm g{A, Bt, M, N, K, K}; pg8::gemm_phase<EpiRes, pg8::StaticOrder, true, true>((PG8_LAS unsigned char*)L, g, So, E); }
    const int c = (int)blockIdx.x, t = c / S, s = c % S;
    SliceOrder Ss; Ss.base = So; Ss.full = full; Ss.R = R; Ss.S = S; Ss.Kr = K / S; Ss.c = c;
    EpiPart EP{PART + ((size_t)(s * R + t) << 16)};
    { pg8::Gemm g{A, Bt, M, N, K / S, K}; pg8::gemm_phase<EpiPart, SliceOrder, true, true>((PG8_LAS unsigned char*)L, g, Ss, EP); }
    xcd_barrier(xbar);
    if (t < R) {
        pg8::Unit u; So.map(full + t, u);
        const int rows_per = 256 / S, mr = u.pm < 32 ? (u.pm >> 3) : 4; const int tid = threadIdx.x;
        for (int e = tid; e < rows_per * 64; e += NTHR) { const int rt = s * rows_per + (e >> 6), c4 = (e & 63) * 4, row = u.pm * 256 + rt, col = u.pn * 256 + c4;
            f32x4 sum = (f32x4){0.f, 0.f, 0.f, 0.f};
#pragma unroll 8
            for (int s2 = 0; s2 < S; ++s2) sum += __builtin_nontemporal_load((const f32x4*)(PART + ((size_t)(s2 * R + t) << 16) + rt * 256 + c4));
            const f32x4 g = *(const f32x4*)(E.modv + (size_t)mr * MODW + col);
            const float* src = (row < MLAT ? E.resL + (size_t)row * DM : E.resC + (size_t)(row - MLAT) * DM) + col;
            const f32x4 xv = __builtin_nontemporal_load((const f32x4*)src) + g * sum;
            *(f32x4*)(E.X + (size_t)row * DM + col) = xv;
            if (E.XS) { const f32x4 cw = *(const f32x4*)(E.nw + col) * (*(const f32x4*)(E.scv + (size_t)mr * MODW + col) + 1.f), y = xv * cw;
                u32x2 w; w.x = pk2(y[0], y[1]); w.y = pk2(y[2], y[3]); *(u32x2*)(E.XS + (size_t)row * DM + col) = w;
                const float ss = wave_sum((xv[0] * xv[0] + xv[1] * xv[1]) + (xv[2] * xv[2] + xv[3] * xv[3]));
                if ((tid & 63) == 0) __hip_atomic_fetch_add(E.rss + row, ss, __ATOMIC_RELAXED, __HIP_MEMORY_SCOPE_AGENT); } }
    }
}

__global__ void __launch_bounds__(NTHR, 2) fwd_kernel(Args a) {
    extern __shared__ __attribute__((aligned(16))) unsigned char lds_raw[];
    LAS unsigned char* L = (LAS unsigned char*)lds_raw;
    cg::grid_group grid = cg::this_grid();
    const int G = gridDim.x;
    unsigned char* ws = a.ws;
    if (threadIdx.x < 8) ((LAS unsigned*)(L + XB_LDS_OFF))[threadIdx.x] = 0u;
    __syncthreads();
    XcdBarrier xbar = xcd_barrier_post((unsigned*)(ws + WS_CTL), (volatile LAS unsigned*)(L + XB_LDS_OFF));
#define RUN(k) (a.ph_lo <= (k) && (k) < a.ph_hi)
#ifndef MK_COOP_SYNC0
#define MK_COOP_SYNC0 0
#endif
#define SEAM(k) do { if (RUN(k) && RUN((k) + 1)) { if (MK_COOP_SYNC0 && (k) == 0) grid.sync(); else xcd_barrier(xbar); } } while (0)
#define FRESH() int tid = threadIdx.x; asm volatile("" : "+v"(tid)); const int lane = tid & 63, wave = __builtin_amdgcn_readfirstlane(tid >> 6); int l = l_; asm volatile("" : "+s"(l)); int Gl = gridDim.x; asm volatile("" : "+s"(Gl)); (void)lane; (void)wave; (void)l; (void)Gl

    #ifndef NO_P0
    if (RUN(0)) { const int l_ = 0; FRESH(); phase_p0(a, L, tid, lane, wave); }
#ifdef PROBE_DUP_P0
    __syncthreads();
    if (RUN(0)) { const int l_ = 0; FRESH(); phase_p0(a, L, tid, lane, wave); }
#endif
#endif
    SEAM(0);
    float* X = (float*)(ws + WS_X); bf16_t* XN = (bf16_t*)(ws + WS_XN); bf16_t* Y = (bf16_t*)(ws + WS_Y); bf16_t* Ab = (bf16_t*)(ws + WS_A);
    const float* MOD = (const float*)(ws + WS_MOD);
#pragma unroll 1
    for (int l_ = 0; l_ < 2; ++l_) {
        const int ph = PH_L0 + PH_PER_L * l_;
#define LAYER_VARS() FRESH(); const bool last = (l == 1); const float* resL = l == 0 ? a.in[0] : X; const float* resC = l == 0 ? a.in[2] : X + (size_t)MLAT * DM; const float* modl = MOD + (size_t)l * 5 * MODW; const int Mo = last ? MLAT : MTOT; (void)last; (void)resL; (void)resC; (void)modl; (void)Mo
        if (RUN(ph + 0) && l_ == 0) { LAYER_VARS(); phase_norm(resL, resC, a.in[6] + (size_t)l * DM, modl, 0, XN, MTOT, lane, wave);
            float* FU = (float*)(ws + WS_FUSE);
#pragma unroll 1
            for (int i = blockIdx.x * NTHR + tid; i < 3 * MTOT; i += Gl * NTHR) ((float*)(ws + WS_FUSE + FU_RSS))[i] = 0.f;
            bias_gemv(MOD + 3 * DM, (const bf16_t*)(ws + WS_WFF1), DFF, (float*)(ws + WS_FUSE + FU_BIAS2), DFF, L, tid, lane, wave);
            bias_gemv(MOD + (size_t)5 * MODW + 3 * DM, (const bf16_t*)(ws + WS_WFF1 + 32 * MiB), DFF, (float*)(ws + WS_FUSE + FU_BIAS2) + 5 * DFF, DFF, L, tid, lane, wave);
            bias_gemv(MOD + (size_t)5 * MODW, (const bf16_t*)(ws + WS_WIN + 27 * MiB), INWP, (float*)(ws + WS_FUSE + FU_BIAS1), INWP, L, tid, lane, wave); (void)FU; }
        if (l_ == 0) SEAM(ph + 0);
        if (RUN(ph + 1)) { LAYER_VARS(); EpiIn E{Ab, (float*)(ws + WS_GATES), l == 0 ? (const float*)nullptr : (const float*)(ws + WS_FUSE + FU_RSS) + MTOT, (const float*)(ws + WS_FUSE + FU_BIAS1)}; run_gemm(L, XN, (const bf16_t*)(ws + WS_WIN + (size_t)l * 27 * MiB), MTOT, INWP, DM, E); }
#ifdef PROBE_DUP_GB
        if (RUN(ph + 1)) { __syncthreads(); LAYER_VARS(); EpiIn E{Ab, (float*)(ws + WS_GATES), l == 0 ? (const float*)nullptr : (const float*)(ws + WS_FUSE + FU_RSS) + MTOT, (const float*)(ws + WS_FUSE + FU_BIAS1)}; run_gemm(L, XN, (const bf16_t*)(ws + WS_WIN + (size_t)l * 27 * MiB), MTOT, INWP, DM, E); }
#endif
        SEAM(ph + 1);
#ifdef PROBE_DUP_MIX
        for (int rep_ = 0; rep_ < 2; ++rep_) {
#endif
        if (RUN(ph + 2)) { LAYER_VARS();
            if (blockIdx.x & 1) {
                for (int j = Gl - 1 - (int)blockIdx.x; j < 1152; j += Gl) s5_phase_c(a, l, L, j * 8 + wave, lane, wave);
                __syncthreads();
                for (int t = blockIdx.x; t < 864; t += Gl) la_phase_c(a, l, L, t, tid, lane, wave);
            } else {
                for (int t = blockIdx.x; t < 864; t += Gl) la_phase_c(a, l, L, t, tid, lane, wave);
                __syncthreads();
                for (int j = Gl - 1 - (int)blockIdx.x; j < 1152; j += Gl) s5_phase_c(a, l, L, j * 8 + wave, lane, wave);
            }
        }
        SEAM(ph + 2);
        #ifndef NO_D
        if (RUN(ph + 3)) { LAYER_VARS(); la_phase_d(a, tid); s5_phase_d(a, l, tid); }
#ifdef PROBE_DUP_D
        if (RUN(ph + 3)) { xcd_barrier(xbar); LAYER_VARS(); la_phase_d(a, tid); s5_phase_d(a, l, tid); }
#endif
#endif
        SEAM(ph + 3);
        if (RUN(ph + 4)) { LAYER_VARS();
            if (blockIdx.x & 1) {
                for (int j = Gl - 1 - (int)blockIdx.x; j < 576; j += Gl) s5_phase_e(a, l, last, L, j * 8 + wave, lane, wave);
                __syncthreads();
                for (int t = blockIdx.x; t < 864; t += Gl) { if (last && (t % 18) < 2) continue; la_phase_e(a, l, L, t, tid, lane, wave); __syncthreads(); }
            } else {
                for (int t = blockIdx.x; t < 864; t += Gl) { if (last && (t % 18) < 2) continue; la_phase_e(a, l, L, t, tid, lane, wave); __syncthreads(); }
                __syncthreads();
                for (int j = Gl - 1 - (int)blockIdx.x; j < 576; j += Gl) s5_phase_e(a, l, last, L, j * 8 + wave, lane, wave);
            }
            __syncthreads();
        }
        SEAM(ph + 4);
#ifdef PROBE_DUP_MIX
        }
#endif
        if (RUN(ph + 5)) { LAYER_VARS(); EpiGlu E{Y, a.in[19] + (size_t)l * 1024}; run_gemm(L, (const bf16_t*)(ws + WS_G), (const bf16_t*)(ws + WS_WGLU + (size_t)l * 1 * MiB), Mo, 1024, 512, E); }
        SEAM(ph + 5);
        if (RUN(ph + 6)) { LAYER_VARS(); EpiRes E{X, resL, resC, modl + 2 * DM, XN, a.in[7] + (size_t)l * DM, modl + 4 * DM, (float*)(ws + WS_FUSE + FU_RSS) + (l == 0 ? 0 : 2 * MTOT)}; run_gemm_res(L, Y, (const bf16_t*)(ws + WS_WOUT + (size_t)l * 8 * MiB), Mo, DM, DM, E, (float*)(ws + WS_PART), xbar); }
        SEAM(ph + 6);
        if (RUN(ph + 8)) { LAYER_VARS(); EpiFF1 E{(bf16_t*)(ws + WS_H), (const float*)(ws + WS_FUSE + FU_RSS) + (l == 0 ? 0 : 2 * MTOT), (const float*)(ws + WS_FUSE + FU_BIAS2) + (size_t)l * 5 * DFF}; run_gemm(L, XN, (const bf16_t*)(ws + WS_WFF1 + (size_t)l * 32 * MiB), Mo, DFF, DM, E); }
#ifdef PROBE_DUP_GI
        if (RUN(ph + 8)) { __syncthreads(); LAYER_VARS(); EpiFF1 E{(bf16_t*)(ws + WS_H), (const float*)(ws + WS_FUSE + FU_RSS) + (l == 0 ? 0 : 2 * MTOT), (const float*)(ws + WS_FUSE + FU_BIAS2) + (size_t)l * 5 * DFF}; run_gemm(L, XN, (const bf16_t*)(ws + WS_WFF1 + (size_t)l * 32 * MiB), Mo, DFF, DM, E); }
#endif
        SEAM(ph + 8);
        if (RUN(ph + 9)) { LAYER_VARS(); EpiRes E{X, X, X + (size_t)MLAT * DM, modl + 5 * DM, l == 0 ? XN : (bf16_t*)nullptr, a.in[6] + (size_t)DM, MOD + (size_t)5 * MODW + DM, (float*)(ws + WS_FUSE + FU_RSS) + MTOT}; run_gemm_res(L, (const bf16_t*)(ws + WS_H), (const bf16_t*)(ws + WS_WFF2 + (size_t)l * 32 * MiB), Mo, DM, DFF, E, (float*)(ws + WS_PART), xbar); }
        SEAM(ph + 9);
    }
#ifdef PROBE_SYNCS
    for (int i_ = 0; i_ < PROBE_SYNCS; ++i_) xcd_barrier(xbar);
#endif
    if (RUN(PH_FINAL)) { const int l_ = 0; FRESH(); phase_final(X, a.in[27], a.out, lane, wave); }
}

#ifndef MK_N_LAUNCHES
#define MK_N_LAUNCHES 1
#endif

extern "C" void kernel_launch(void* const* d_in, const int* in_sizes, int n_in, void* d_out, int out_size, void* d_ws, size_t ws_size, hipStream_t stream) {
    static int grid = 0;
    if (grid == 0) {
        if (n_in != 28 || ws_size < WS_END) { fprintf(stderr, "kernel_launch: unexpected n_in %d / ws %zu\n", n_in, ws_size); grid = -1; return; }
        int dev = 0, cus = 0, per_cu = 0;
        hipGetDevice(&dev); hipDeviceGetAttribute(&cus, hipDeviceAttributeMultiprocessorCount, dev);
        if (hipFuncSetAttribute((const void*)fwd_kernel, hipFuncAttributeMaxDynamicSharedMemorySize, LDS_BYTES) != hipSuccess) { fprintf(stderr, "kernel_launch: hipFuncSetAttribute failed\n"); grid = -1; return; }
        if (hipOccupancyMaxActiveBlocksPerMultiprocessor(&per_cu, (const void*)fwd_kernel, NTHR, LDS_BYTES) != hipSuccess || per_cu < 1) { fprintf(stderr, "kernel_launch: occupancy query gave %d\n", per_cu); per_cu = 1; }
        (void)hipGetLastError();
        grid = cus * (per_cu > 1 ? 1 : per_cu);
        if (grid <= 0) grid = 256;
    }
    if (grid < 0) return;
    if (hipMemsetAsync((char*)d_ws + WS_CTL, 0, 65536, stream) != hipSuccess) { fprintf(stderr, "kernel_launch: memset failed\n"); return; }
    Args a{};
    for (int i = 0; i < 28; ++i) a.in[i] = (const float*)d_in[i];
    a.out = (float*)d_out; a.ws = (unsigned char*)d_ws;
#if MK_N_LAUNCHES == 1
    a.ph_lo = 0; a.ph_hi = N_PHASES;
    void* args[] = {&a};
    hipError_t e = hipLaunchCooperativeKernel((const void*)fwd_kernel, dim3(grid), dim3(NTHR), args, LDS_BYTES, stream);
    if (e != hipSuccess) fprintf(stderr, "cooperative launch failed: %s (grid %d)\n", hipGetErrorString(e), grid);
#else
    for (int p = 0; p < N_PHASES; ++p) { a.ph_lo = p; a.ph_hi = p + 1; hipLaunchKernelGGL(fwd_kernel, dim3(grid), dim3(NTHR), LDS_BYTES, stream, a); }
#endif
}
```

```cpp
#include <hip/hip_runtime.h>
#include <hip/hip_cooperative_groups.h>
#include <cstdio>
#include <cstdint>
namespace cg = cooperative_groups;
namespace pg8 {
#define PG8_LAS __attribute__((address_space(3)))
typedef unsigned short bf16_t;
typedef short bf16x8 __attribute__((ext_vector_type(8)));
typedef float f32x4 __attribute__((ext_vector_type(4)));
typedef unsigned u32x4 __attribute__((ext_vector_type(4)));
constexpr int BM = 256, BK = 64, HALF = 128, HTB = HALF * BK * 2  , STAGE_BYTES = 8 * HTB, NXCD = 8, WGM = 2;

__host__ __device__ __forceinline__ int lds_byte(int r, int c) { const int st = (r >> 4) * 2 + (c >> 5), rr = r & 15, cc = c & 31, ob = rr * 64 + cc * 2; return st * 1024 + (ob ^ (((ob >> 9) & 1) << 5)); }
__host__ __device__ __forceinline__ void stage_rc(int b, int& R, int& C) { const int st = b / 1024, sb = b % 1024, swz = sb ^ (((sb >> 9) & 1) << 5); R = (st >> 1) * 16 + swz / 64; C = (st & 1) * 32 + (swz % 64) / 2; }
__host__ __device__ __forceinline__ int perm32(int rho) { const int n = rho >> 4, i = rho & 15; return 8 * (i >> 2) + 4 * n + (i & 3); }

struct Unit { int pm, pn, k0; };
struct Gemm { const bf16_t* A; const bf16_t* Bt; int M, N, K, ld; };

struct StaticOrder {
    int nM, nN, nwg, G, c, limit;
    __host__ __device__ void init(int M, int N, int G_, int c_) { nM = M / BM; nN = N / BM; nwg = nM * nN; G = G_; c = c_; limit = nwg; }
    __host__ __device__ void map(int wgid_in, Unit& u) const { int wgid = wgid_in; { const int q = nwg / NXCD, r = nwg % NXCD, xcd = wgid % NXCD, off = wgid / NXCD; wgid = (xcd < r ? xcd * (q + 1) : r * (q + 1) + (xcd - r) * q) + off; }
        const int nig = WGM * nN, gid = wgid / nig, fm = gid * WGM, gsz = (nM - fm) < WGM ? (nM - fm) : WGM; u.pm = fm + ((wgid % nig) % gsz); u.pn = (wgid % nig) / gsz; u.k0 = 0; }
    __host__ __device__ bool next(int i, Unit& u) const {
        const long L = (long)i * G + c; if (L >= limit) return false; u.k0 = 0;
        int wgid = (int)L; { const int q = nwg / NXCD, r = nwg % NXCD, xcd = wgid % NXCD, off = wgid / NXCD; wgid = (xcd < r ? xcd * (q + 1) : r * (q + 1) + (xcd - r) * q) + off; }
        const int nig = WGM * nN, gid = wgid / nig, fm = gid * WGM, gsz = (nM - fm) < WGM ? (nM - fm) : WGM;
        u.pm = fm + ((wgid % nig) % gsz); u.pn = (wgid % nig) / gsz; return true;
    }
    __device__ __forceinline__ void a_ready(const Unit&) const {}
    __device__ __forceinline__ void done(const Unit&) const {}
};

__device__ __forceinline__ unsigned cvt_pk_bf16(float lo, float hi) { unsigned r; asm volatile("v_cvt_pk_bf16_f32 %0, %1, %2" : "=v"(r) : "v"(lo), "v"(hi)); return r; }
template <class Epi, class Sched, bool ALIGN_EPI = false, bool SP2 = false>
__device__ __forceinline__ void gemm_phase(PG8_LAS unsigned char* lds, const Gemm g, const Sched& S, const Epi& E) {
    int tid_ = threadIdx.x; asm volatile("" : "+v"(tid_));
    const int tid = tid_, wid = __builtin_amdgcn_readfirstlane(tid >> 6), lane = tid & 63, wr = wid >> 2, wc = wid & 3, fr = lane & 15, fq = lane >> 4;
    const int K = g.ld, nt = g.K / BK;
    unsigned voffA[2], voffB[2];
#pragma unroll
    for (int i = 0; i < 2; ++i) { int R, C; stage_rc(tid * 16 + i * 8192, R, C); const int Rb = Epi::PERM ? ((R & ~31) + perm32(R & 31)) : R;
        voffA[i] = (unsigned)(R * K + C) * 2u; voffB[i] = (unsigned)(Rb * K + C) * 2u; }
    const size_t kstep = (size_t)(BK * 2);
    const size_t hstep = (size_t)HALF * K * 2;
    const size_t tstep = 2 * hstep;
    const unsigned ldsw = (unsigned)wid * 1024u;
    const int aoff = lds_byte(wr * 64 + fr, fq * 8), boff = lds_byte(wc * 32 + fr, fq * 8);
#define PG8_SA(b, h) (((b) * 2 + (h)) * HTB)
#define PG8_SB(b, h) ((4 + (b) * 2 + (h)) * HTB)
#define PG8_STAGE(bufoff, gbase, voff) do { _Pragma("unroll") for (int _i = 0; _i < 2; ++_i) \
        __builtin_amdgcn_global_load_lds((const unsigned*)((const char*)(gbase) + (voff)[_i]), (PG8_LAS unsigned*)(lds + (bufoff) + ldsw + _i * 8192), 16, 0, 0); } while (0)
#define PG8_LDA(dst, b, h) do { _Pragma("unroll") for (int m = 0; m < 4; ++m) _Pragma("unroll") for (int k = 0; k < 2; ++k) dst[m][k] = *(const PG8_LAS bf16x8*)(lds + PG8_SA(b, h) + aoff + m * 2048 + k * 1024); } while (0)
#define PG8_LDB(dst, b, h) do { _Pragma("unroll") for (int n = 0; n < 2; ++n) _Pragma("unroll") for (int k = 0; k < 2; ++k) dst[n][k] = *(const PG8_LAS bf16x8*)(lds + PG8_SB(b, h) + boff + n * 2048 + k * 1024); } while (0)
#define PG8_MMA(ai, bj, At, Bt) do { __builtin_amdgcn_s_setprio(1); _Pragma("unroll") for (int m = 0; m < 4; ++m) _Pragma("unroll") for (int n = 0; n < 2; ++n) _Pragma("unroll") for (int k = 0; k < 2; ++k) \
        acc[ai][bj][m][n] = __builtin_amdgcn_mfma_f32_16x16x32_bf16(Bt[n][k], At[m][k], acc[ai][bj][m][n], 0, 0, 0); __builtin_amdgcn_s_setprio(0); } while (0)
#define PG8_WAIT_V(n) asm volatile("s_waitcnt vmcnt(" #n ")" ::: "memory")
#define PG8_WAIT_L(n) asm volatile("s_waitcnt lgkmcnt(" #n ")" ::: "memory")
#define PG8_BAR __builtin_amdgcn_s_barrier()
#define PG8_SCHED __builtin_amdgcn_sched_barrier(0)
    Unit cur, nxt; int ui = 0;
    if (!S.next(0, cur)) return;
    f32x4 acc[2][2][4][2];
#pragma unroll
    for (int a = 0; a < 2; ++a)
#pragma unroll
        for (int b = 0; b < 2; ++b)
#pragma unroll
            for (int m = 0; m < 4; ++m)
#pragma unroll
                for (int n = 0; n < 2; ++n) acc[a][b][m][n] = (f32x4){0.f, 0.f, 0.f, 0.f};
    bf16x8 At[4][2], B0[2][2], B1[2][2];
    const char* cA = (const char*)g.A + (size_t)cur.pm * tstep + (size_t)cur.k0 * 2; const char* cB = (const char*)g.Bt + (size_t)cur.pn * tstep + (size_t)cur.k0 * 2;
    S.a_ready(cur);
    if constexpr (SP2) {
        PG8_STAGE(PG8_SB(0, 0), cB, voffB); PG8_STAGE(PG8_SB(0, 1), cB + hstep, voffB); PG8_STAGE(PG8_SA(0, 0), cA, voffA); PG8_STAGE(PG8_SA(0, 1), cA + hstep, voffA);
        if (wr == 1) PG8_BAR;
        PG8_WAIT_V(2); PG8_BAR;
        PG8_STAGE(PG8_SB(1, 0), cB + kstep, voffB); PG8_STAGE(PG8_SA(1, 0), cA + kstep, voffA); PG8_STAGE(PG8_SB(1, 1), cB + hstep + kstep, voffB);
        PG8_WAIT_V(6); PG8_BAR;
    } else {
        PG8_STAGE(PG8_SB(0, 0), cB, voffB); PG8_STAGE(PG8_SA(0, 0), cA, voffA); PG8_STAGE(PG8_SB(0, 1), cB + hstep, voffB); PG8_STAGE(PG8_SA(0, 1), cA + hstep, voffA);
        if (wr == 1) PG8_BAR;
        PG8_WAIT_V(4); PG8_BAR;
        PG8_STAGE(PG8_SB(1, 0), cB + kstep, voffB); PG8_STAGE(PG8_SA(1, 0), cA + kstep, voffA); PG8_STAGE(PG8_SB(1, 1), cB + hstep + kstep, voffB);
        PG8_WAIT_V(6); PG8_BAR;
    }
    for (;;) {
        const bool has_next = S.next(ui + 1, nxt);
        const char* nA = has_next ? (const char*)g.A + (size_t)nxt.pm * tstep + (size_t)nxt.k0 * 2 : cA; const char* nB = has_next ? (const char*)g.Bt + (size_t)nxt.pn * tstep + (size_t)nxt.k0 * 2 : cB;
        for (int t = 0; t < nt; t += 2) {
            const bool last = (t == nt - 2);
            const char* a1 = cA + (size_t)(t + 1) * kstep;
            const char* a2 = last ? nA : cA + (size_t)(t + 2) * kstep; const char* b2 = last ? nB : cB + (size_t)(t + 2) * kstep;
            const char* a3 = a2 + kstep; const char* b3 = b2 + kstep;
            if (last && has_next) S.a_ready(nxt);
            if constexpr (SP2) {
            PG8_LDB(B0, 0, 0); PG8_LDB(B1, 0, 1); PG8_SCHED; PG8_LDA(At, 0, 0); PG8_STAGE(PG8_SA(1, 1), a1 + hstep, voffA);
            PG8_WAIT_V(8); PG8_WAIT_L(0); PG8_BAR; PG8_MMA(0, 0, At, B0); PG8_MMA(0, 1, At, B1); PG8_BAR; PG8_SCHED;
            PG8_LDA(At, 0, 1); PG8_STAGE(PG8_SB(0, 0), b2, voffB); PG8_STAGE(PG8_SB(0, 1), b2 + hstep, voffB); PG8_STAGE(PG8_SA(0, 0), a2, voffA);
            PG8_WAIT_V(8); PG8_WAIT_L(0); PG8_BAR; PG8_MMA(1, 0, At, B0); PG8_MMA(1, 1, At, B1); PG8_BAR; PG8_SCHED;
            PG8_LDB(B0, 1, 0); PG8_LDB(B1, 1, 1); PG8_SCHED; PG8_LDA(At, 1, 0); PG8_STAGE(PG8_SA(0, 1), a2 + hstep, voffA);
            PG8_WAIT_V(8); PG8_WAIT_L(0); PG8_BAR; PG8_MMA(0, 0, At, B0); PG8_MMA(0, 1, At, B1); PG8_BAR; PG8_SCHED;
            PG8_LDA(At, 1, 1); PG8_STAGE(PG8_SB(1, 0), b3, voffB); PG8_STAGE(PG8_SB(1, 1), b3 + hstep, voffB); PG8_STAGE(PG8_SA(1, 0), a3, voffA);
            PG8_WAIT_V(8); PG8_WAIT_L(0); PG8_BAR; PG8_MMA(1, 0, At, B0); PG8_MMA(1, 1, At, B1); PG8_BAR; PG8_SCHED;
            } else {
            PG8_LDB(B0, 0, 0); PG8_SCHED; PG8_LDA(At, 0, 0); PG8_STAGE(PG8_SA(1, 1), a1 + hstep, voffA);
            PG8_WAIT_L(8); PG8_BAR; PG8_WAIT_L(0); PG8_MMA(0, 0, At, B0); PG8_BAR; PG8_SCHED;
            PG8_LDB(B1, 0, 1); PG8_STAGE(PG8_SB(0, 0), b2, voffB);
            PG8_BAR; PG8_WAIT_L(0); PG8_MMA(0, 1, At, B1); PG8_BAR;
            PG8_LDA(At, 0, 1); PG8_STAGE(PG8_SA(0, 0), a2, voffA);
            PG8_BAR; PG8_WAIT_L(0); PG8_MMA(1, 0, At, B0); PG8_BAR; PG8_SCHED;
            PG8_STAGE(PG8_SB(0, 1), b2 + hstep, voffB);
            PG8_WAIT_V(6); PG8_BAR; PG8_MMA(1, 1, At, B1); PG8_BAR;
            PG8_LDB(B0, 1, 0); PG8_SCHED; PG8_LDA(At, 1, 0); PG8_STAGE(PG8_SA(0, 1), a2 + hstep, voffA);
            PG8_WAIT_L(8); PG8_BAR; PG8_WAIT_L(0); PG8_MMA(0, 0, At, B0); PG8_BAR; PG8_SCHED;
            PG8_LDB(B1, 1, 1); PG8_STAGE(PG8_SB(1, 0), b3, voffB);
            PG8_BAR; PG8_WAIT_L(0); PG8_MMA(0, 1, At, B1); PG8_BAR;
            PG8_LDA(At, 1, 1); PG8_STAGE(PG8_SA(1, 0), a3, voffA);
            PG8_BAR; PG8_WAIT_L(0); PG8_MMA(1, 0, At, B0); PG8_BAR; PG8_SCHED;
            PG8_STAGE(PG8_SB(1, 1), b3 + hstep, voffB);
            PG8_WAIT_V(6); PG8_BAR; PG8_MMA(1, 1, At, B1); PG8_BAR;
            }
        }
        if constexpr (ALIGN_EPI) { if (wr == 0) PG8_BAR; }
        if constexpr (!Epi::AFTER_DRAIN) { E(acc, cur, wr, wc, fr, fq); S.done(cur); }
        if (!has_next) break;
#pragma unroll
        for (int a = 0; a < 2; ++a)
#pragma unroll
            for (int b = 0; b < 2; ++b)
#pragma unroll
                for (int m = 0; m < 4; ++m)
#pragma unroll
                    for (int n = 0; n < 2; ++n) acc[a][b][m][n] = (f32x4){0.f, 0.f, 0.f, 0.f};
        cur = nxt; cA = nA; cB = nB; ++ui;
        if constexpr (ALIGN_EPI) { if (wr == 1) PG8_BAR; }
    }
    PG8_WAIT_V(0);
    if constexpr (!ALIGN_EPI) { if (wr == 0) PG8_BAR; }
    PG8_BAR;
    if constexpr (Epi::AFTER_DRAIN) { E.fused(acc, cur, wr, wc, fr, fq, lds, wid, lane); S.done(cur); }
#undef PG8_SA
#undef PG8_SB
#undef PG8_STAGE
#undef PG8_LDA
#undef PG8_LDB
#undef PG8_MMA
#undef PG8_WAIT_V
#undef PG8_WAIT_L
#undef PG8_BAR
#undef PG8_SCHED
}
}

#define LAS __attribute__((address_space(3)))
typedef unsigned short bf16_t;
typedef short bf16x8 __attribute__((ext_vector_type(8)));
typedef short s16x4 __attribute__((ext_vector_type(4)));
typedef float f32x4 __attribute__((ext_vector_type(4)));
typedef unsigned u32x4 __attribute__((ext_vector_type(4)));
typedef unsigned u32x2 __attribute__((ext_vector_type(2)));

constexpr int DM = 2048, NBATCH = 4, SEQ = 2048, CTXL = 256;
constexpr int MLAT = NBATCH * SEQ, MCTX = NBATCH * CTXL, MTOT = MLAT + MCTX;
constexpr int INW = 6680, INWP = 6912, AW = 6656, DFF = 8192, MODW = 6 * DM;
constexpr int NHEAD = 6;
constexpr int COL_R = 512, COL_M = 3584;
constexpr int NPB = 18, NSC = 36;
constexpr float EPSN = 1e-6f;
constexpr int NWAVES = 8, NTHR = 512;
constexpr int LDS_BYTES = 148480, XB_LDS_OFF = 147456;

constexpr size_t MiB = 1u << 20;
constexpr size_t WS_WIN = 0;
constexpr size_t WS_WOUT = 54 * MiB;
constexpr size_t WS_WGLU = 70 * MiB;
constexpr size_t WS_WFF1 = 72 * MiB;
constexpr size_t WS_WFF2 = 136 * MiB;
constexpr size_t WS_MOD = 200 * MiB;
constexpr size_t WS_ROPE = 201 * MiB;
constexpr size_t WS_S5T = 202 * MiB;
constexpr size_t WS_X = 204 * MiB;
constexpr size_t WS_XN = 276 * MiB;
constexpr size_t WS_Y = 312 * MiB;
constexpr size_t WS_G = 348 * MiB;
constexpr size_t WS_GATES = 357 * MiB;
constexpr size_t WS_SMALL = 358 * MiB;
constexpr size_t WS_ES = 362 * MiB;
constexpr size_t WS_XIN = 367 * MiB;
constexpr size_t WS_A = 372 * MiB;
constexpr size_t WS_KV = 489 * MiB;
constexpr size_t WS_CB = 543 * MiB;
constexpr size_t WS_H = WS_A;
constexpr size_t WS_CTL = 597 * MiB;
constexpr size_t WS_PART = 598 * MiB;
constexpr size_t WS_FUSE = 662 * MiB;
constexpr size_t FU_BIAS2 = 0, FU_BIAS1 = 327680, FU_RSS = 327680 + 138240;
constexpr size_t WS_GS = 663 * MiB;
constexpr size_t WS_END = 666 * MiB;
constexpr size_t S5_ABR = 0, S5_ABI = 32768, S5_A64R = 65536, S5_A64I = 98304, S5_BBT = 131072  , S5_CT = 131072 + 524288;
constexpr size_t SM_KN = 0, SM_NBEF = 1 * MiB, SM_SC = 2 * MiB, SM_MPREV = 3 * MiB;

__device__ __forceinline__ unsigned f2bf(float f) { unsigned u = __builtin_bit_cast(unsigned, f); return (u + 0x7fffu + ((u >> 16) & 1u)) >> 16; }
typedef __bf16 hwbf16x2_t __attribute__((ext_vector_type(2)));
typedef float hwf32x2_t __attribute__((ext_vector_type(2)));
__device__ __forceinline__ unsigned pk2(float lo, float hi) { const hwf32x2_t v = {lo, hi}; const hwbf16x2_t b = __builtin_convertvector(v, hwbf16x2_t); return __builtin_bit_cast(unsigned, b); }
__device__ __forceinline__ float bflo(unsigned u) { return __builtin_bit_cast(float, u << 16); }
__device__ __forceinline__ float bfhi(unsigned u) { return __builtin_bit_cast(float, u & 0xffff0000u); }
__device__ __forceinline__ float bf1(bf16_t h) { return __builtin_bit_cast(float, (unsigned)h << 16); }
__device__ __forceinline__ float sigmoidf_(float x) { return __builtin_amdgcn_rcpf(1.f + __expf(-x)); }
__device__ __forceinline__ float logsigf_(float x) { return fminf(x, 0.f) - log1pf(expf(-fabsf(x))); }
__device__ __forceinline__ f32x4 mfma16(bf16x8 a, bf16x8 b, f32x4 c) { return __builtin_amdgcn_mfma_f32_16x16x32_bf16(a, b, c, 0, 0, 0); }

__device__ __forceinline__ int pb_row(int b, int pb) { return pb < 2 ? MLAT + b * CTXL + pb * 128 : b * SEQ + (pb - 2) * 128; }
__device__ __forceinline__ int sc_row(int b, int sc) { return sc < 4 ? MLAT + b * CTXL + sc * 64 : b * SEQ + (sc - 4) * 64; }
__device__ __forceinline__ int seq_pb(int d, int k) { return d == 0 ? k : (k < 2 ? 1 - k : 19 - k); }
__device__ __forceinline__ int seq_sc(int d, int k) { return d == 0 ? k : (k < 4 ? 3 - k : 39 - k); }

struct Args { const float* in[28]; float* out; unsigned char* ws; int ph_lo, ph_hi; };

struct EpiIn {
    static constexpr bool PERM = true, AFTER_DRAIN = false;
    bf16_t* A; float* gates; const float* rss; const float* bias;
    __device__ __forceinline__ void operator()(const f32x4 (&acc)[2][2][4][2], const pg8::Unit& u, int wr, int wc, int fr, int fq) const {
        const int row0 = u.pm * 256 + wr * 64 + fr, col0 = u.pn * 256 + wc * 32 + 8 * fq;
        const int mr = u.pm < 32 ? (u.pm >> 3) : 4;
        float rstd[2][4];
#pragma unroll
        for (int ai = 0; ai < 2; ++ai)
#pragma unroll
            for (int m = 0; m < 4; ++m) rstd[ai][m] = rss ? rsqrtf(rss[row0 + ai * 128 + m * 16] * (1.f / DM) + EPSN) : 1.f;
#pragma unroll
        for (int bj = 0; bj < 2; ++bj) {
            f32x4 b0 = (f32x4){0.f, 0.f, 0.f, 0.f}, b1 = b0;
            if (rss) { const float* bp = bias + (size_t)mr * INWP + col0 + bj * 128; b0 = *(const f32x4*)bp; b1 = *(const f32x4*)(bp + 4); }
#pragma unroll
            for (int ai = 0; ai < 2; ++ai)
#pragma unroll
                for (int m = 0; m < 4; ++m) { const int row = row0 + ai * 128 + m * 16;
                    const f32x4 v0 = acc[ai][bj][m][0] * rstd[ai][m] + b0, v1 = acc[ai][bj][m][1] * rstd[ai][m] + b1;
                    if (u.pn < 26) { u32x4 w; w.x = pk2(v0[0], v0[1]); w.y = pk2(v0[2], v0[3]); w.z = pk2(v1[0], v1[1]); w.w = pk2(v1[2], v1[3]);
                        *(u32x4*)(A + (size_t)row * AW + col0 + bj * 128) = w; }
                    else if (bj == 0 && wc == 0 && fq < 3) { float* gp = gates + (size_t)row * 24 + 8 * fq; *(f32x4*)gp = v0; *(f32x4*)(gp + 4) = v1; } }
        }
    }
};
struct EpiGlu {
    static constexpr bool PERM = true, AFTER_DRAIN = false;
    bf16_t* Y; const float* bias;
    __device__ __forceinline__ void operator()(const f32x4 (&acc)[2][2][4][2], const pg8::Unit& u, int wr, int wc, int fr, int fq) const {
        const int row0 = u.pm * 256 + wr * 64 + fr, colo = u.pn * 128 + wc * 32 + 8 * fq;
        const f32x4 b00 = *(const f32x4*)(bias + colo), b01 = *(const f32x4*)(bias + colo + 4), b10 = *(const f32x4*)(bias + 512 + colo), b11 = *(const f32x4*)(bias + 512 + colo + 4);
#pragma unroll
        for (int ai = 0; ai < 2; ++ai)
#pragma unroll
            for (int m = 0; m < 4; ++m) {
                float o[8];
#pragma unroll
                for (int e = 0; e < 4; ++e) { o[e] = (acc[ai][0][m][0][e] + b00[e]) * sigmoidf_(acc[ai][1][m][0][e] + b10[e]); o[4 + e] = (acc[ai][0][m][1][e] + b01[e]) * sigmoidf_(acc[ai][1][m][1][e] + b11[e]); }
                u32x4 w; w.x = pk2(o[0], o[1]); w.y = pk2(o[2], o[3]); w.z = pk2(o[4], o[5]); w.w = pk2(o[6], o[7]);
                *(u32x4*)(Y + (size_t)(row0 + ai * 128 + m * 16) * DM + colo) = w; }
    }
};
struct EpiRes {
    static constexpr bool PERM = true, AFTER_DRAIN = false;
    float* X; const float* resL; const float* resC; const float* modv;
    bf16_t* XS; const float* nw; const float* scv; float* rss;
    __device__ __forceinline__ void operator()(const f32x4 (&acc)[2][2][4][2], const pg8::Unit& u, int wr, int wc, int fr, int fq) const {
        const int row0 = u.pm * 256 + wr * 64 + fr, col0 = u.pn * 256 + wc * 32 + 8 * fq;
        const int mr = u.pm < 32 ? (u.pm >> 3) : 4;
        const float* mv = modv + (size_t)mr * MODW + col0;
        float rs[2][4];
#pragma unroll
        for (int ai = 0; ai < 2; ++ai)
#pragma unroll
            for (int m = 0; m < 4; ++m) rs[ai][m] = 0.f;
#pragma unroll
        for (int bj = 0; bj < 2; ++bj) {
            const f32x4 g0 = *(const f32x4*)(mv + bj * 128), g1 = *(const f32x4*)(mv + bj * 128 + 4);
            f32x4 c0 = (f32x4){0.f, 0.f, 0.f, 0.f}, c1 = c0;
            if (XS) { const float* sp = scv + (size_t)mr * MODW + col0 + bj * 128; const float* np = nw + col0 + bj * 128;
                c0 = *(const f32x4*)np * (*(const f32x4*)sp + 1.f); c1 = *(const f32x4*)(np + 4) * (*(const f32x4*)(sp + 4) + 1.f); }
#pragma unroll
            for (int ai = 0; ai < 2; ++ai)
#pragma unroll
                for (int m = 0; m < 4; ++m) { const int row = row0 + ai * 128 + m * 16;
                    const float* src = (row < MLAT ? resL + (size_t)row * DM : resC + (size_t)(row - MLAT) * DM) + col0 + bj * 128;
                    float* dst = X + (size_t)row * DM + col0 + bj * 128;
                    const f32x4 x0 = __builtin_nontemporal_load((const f32x4*)src) + g0 * acc[ai][bj][m][0], x1 = __builtin_nontemporal_load((const f32x4*)(src + 4)) + g1 * acc[ai][bj][m][1];
                    *(f32x4*)dst = x0; *(f32x4*)(dst + 4) = x1;
                    if (XS) { rs[ai][m] += (x0[0] * x0[0] + x0[1] * x0[1]) + (x0[2] * x0[2] + x0[3] * x0[3]) + (x1[0] * x1[0] + x1[1] * x1[1]) + (x1[2] * x1[2] + x1[3] * x1[3]);
                        const f32x4 y0 = x0 * c0, y1 = x1 * c1; u32x4 w; w.x = pk2(y0[0], y0[1]); w.y = pk2(y0[2], y0[3]); w.z = pk2(y1[0], y1[1]); w.w = pk2(y1[2], y1[3]);
                        *(u32x4*)(XS + (size_t)row * DM + col0 + bj * 128) = w; } }
        }
        if (XS) {
#pragma unroll
            for (int ai = 0; ai < 2; ++ai)
#pragma unroll
                for (int m = 0; m < 4; ++m) { float v = rs[ai][m]; v += __shfl_xor(v, 16); v += __shfl_xor(v, 32);
                    if (fq == 0) __hip_atomic_fetch_add(rss + row0 + ai * 128 + m * 16, v, __ATOMIC_RELAXED, __HIP_MEMORY_SCOPE_AGENT); }
        }
    }
};
struct EpiFF1 {
    static constexpr bool PERM = true, AFTER_DRAIN = false;
    bf16_t* H; const float* rss; const float* bias;
    __device__ __forceinline__ void operator()(const f32x4 (&acc)[2][2][4][2], const pg8::Unit& u, int wr, int wc, int fr, int fq) const {
        const int row0 = u.pm * 256 + wr * 64 + fr, col0 = u.pn * 256 + wc * 32 + 8 * fq;
        const int mr = u.pm < 32 ? (u.pm >> 3) : 4;
        float rstd[2][4];
#pragma unroll
        for (int ai = 0; ai < 2; ++ai)
#pragma unroll
            for (int m = 0; m < 4; ++m) rstd[ai][m] = rsqrtf(rss[row0 + ai * 128 + m * 16] * (1.f / DM) + EPSN);
#pragma unroll
        for (int bj = 0; bj < 2; ++bj) { const float* bp = bias + (size_t)mr * DFF + col0 + bj * 128; const f32x4 b0 = *(const f32x4*)bp, b1 = *(const f32x4*)(bp + 4);
#pragma unroll
            for (int ai = 0; ai < 2; ++ai)
#pragma unroll
                for (int m = 0; m < 4; ++m) { f32x4 v0 = acc[ai][bj][m][0] * rstd[ai][m] + b0, v1 = acc[ai][bj][m][1] * rstd[ai][m] + b1;
#pragma unroll
                    for (int e = 0; e < 4; ++e) { const float a = fmaxf(v0[e], 0.f), b = fmaxf(v1[e], 0.f); v0[e] = a * a; v1[e] = b * b; }
                    u32x4 w; w.x = pk2(v0[0], v0[1]); w.y = pk2(v0[2], v0[3]); w.z = pk2(v1[0], v1[1]); w.w = pk2(v1[2], v1[3]);
                    *(u32x4*)(H + (size_t)(row0 + ai * 128 + m * 16) * DFF + col0 + bj * 128) = w; } }
    }
};

__device__ __forceinline__ void p0_transpose_item(const float* W, int K, int Nsrc, bf16_t* WT, int kb, int n0src, int outrow0, LAS float* scr, int lane) {
    const int k0 = 64 * kb, nn = n0src + (lane & 31);
#pragma unroll
    for (int i = 0; i < 32; ++i) { const int kk = 2 * i + (lane >> 5); scr[kk * 33 + (lane & 31)] = nn < Nsrc ? __builtin_nontemporal_load(W + (size_t)(k0 + kk) * Nsrc + nn) : 0.f; }
    asm volatile("s_waitcnt lgkmcnt(0)" ::: "memory");
    const int c = lane & 7;
#pragma unroll
    for (int j = 0; j < 4; ++j) { const int n = (lane >> 3) + 8 * j; const LAS float* s = scr + (8 * c) * 33 + n;
        u32x4 o; o.x = pk2(s[0 * 33], s[1 * 33]); o.y = pk2(s[2 * 33], s[3 * 33]); o.z = pk2(s[4 * 33], s[5 * 33]); o.w = pk2(s[6 * 33], s[7 * 33]);
        *(u32x4*)(WT + (size_t)(outrow0 + n) * K + k0 + 8 * c) = o; }
    asm volatile("s_waitcnt lgkmcnt(0)" ::: "memory");
}

__device__ __forceinline__ void phase_p0(const Args& a, LAS unsigned char* L, int tid, int lane, int wave) {
    unsigned char* ws = a.ws;
    const int G = gridDim.x, gw = blockIdx.x * NWAVES + wave, NGW = G * NWAVES, gt = blockIdx.x * NTHR + tid, NGT = G * NTHR;
    LAS float* sl = (LAS float*)L;
    for (int i = tid; i < 5 * DM; i += NTHR) { const float v = i < 4 * DM ? a.in[1][i] : a.in[3][i - 4 * DM]; sl[i] = v / (1.f + expf(-v)); }
    __syncthreads();
    float* MOD = (float*)(ws + WS_MOD);
#ifdef PROBE_P0_MODREP
    for (int rp_ = 0; rp_ < 2; ++rp_)
#endif
    for (int it = NGW - 1 - gw; it < 2 * 384; it += NGW) {
        const int l = it / 384, cgp = it % 384, colq = lane & 7, ks = lane >> 3, n0 = cgp * 32 + colq * 4;
        const float* wp = a.in[4] + (size_t)l * DM * MODW + n0;
        f32x4 acc[5];
#pragma unroll
        for (int r = 0; r < 5; ++r) acc[r] = (f32x4){0.f, 0.f, 0.f, 0.f};
#pragma unroll 8
        for (int k = ks; k < DM; k += 8) { const f32x4 w4 = __builtin_nontemporal_load((const f32x4*)(wp + (size_t)k * MODW));
#pragma unroll
            for (int r = 0; r < 5; ++r) acc[r] += w4 * sl[r * DM + k]; }
#pragma unroll
        for (int r = 0; r < 5; ++r)
#pragma unroll
            for (int e = 0; e < 4; ++e) { float v = acc[r][e]; v += __shfl_xor(v, 8); v += __shfl_xor(v, 16); v += __shfl_xor(v, 32); acc[r][e] = v; }
        if (ks == 0) { const f32x4 bb = *(const f32x4*)(a.in[5] + (size_t)l * MODW + n0);
#pragma unroll
            for (int r = 0; r < 5; ++r) *(f32x4*)(MOD + (size_t)(l * 5 + r) * MODW + n0) = acc[r] + bb; }
    }
    LAS float* scr = (LAS float*)(L + 40960 + wave * 8448);
    constexpr int I_IN = 32 * 216, I_OUT = 32 * 64, I_GLU = 8 * 32, I_FF1 = 32 * 256, I_FF2 = 128 * 64, I_L = I_IN + I_OUT + I_GLU + I_FF1 + I_FF2;
#ifdef PROBE_P0_TRREP
    for (int rp_ = 0; rp_ < 2; ++rp_)
#endif
    for (int it = gw; it < 2 * I_L; it += NGW) {
        const int l = it / I_L; int r = it % I_L;
        if (r < I_IN) { const int kb = r / 216, nb = r % 216; p0_transpose_item(a.in[8] + (size_t)l * DM * INW, DM, INW, (bf16_t*)(ws + WS_WIN + (size_t)l * 27 * MiB), kb, 32 * nb, 32 * nb, scr, lane); continue; } r -= I_IN;
        if (r < I_OUT) { const int kb = r / 64, nb = r % 64; p0_transpose_item(a.in[9] + (size_t)l * DM * DM, DM, DM, (bf16_t*)(ws + WS_WOUT + (size_t)l * 8 * MiB), kb, 32 * nb, 32 * nb, scr, lane); continue; } r -= I_OUT;
        if (r < I_GLU) { const int kb = r / 32, nb = r % 32, n0 = 32 * nb, orow = ((n0 & 511) >> 7) * 256 + (n0 >> 9) * 128 + (n0 & 127);
            p0_transpose_item(a.in[18] + (size_t)l * 512 * 1024, 512, 1024, (bf16_t*)(ws + WS_WGLU + (size_t)l * 1 * MiB), kb, n0, orow, scr, lane); continue; } r -= I_GLU;
        if (r < I_FF1) { const int kb = r / 256, nb = r % 256; p0_transpose_item(a.in[25] + (size_t)l * DM * DFF, DM, DFF, (bf16_t*)(ws + WS_WFF1 + (size_t)l * 32 * MiB), kb, 32 * nb, 32 * nb, scr, lane); continue; } r -= I_FF1;
        { const int kb = r / 64, nb = r % 64; p0_transpose_item(a.in[26] + (size_t)l * DFF * DM, DFF, DM, (bf16_t*)(ws + WS_WFF2 + (size_t)l * 32 * MiB), kb, 32 * nb, 32 * nb, scr, lane); }
    }
    if (gt < 8192) {
        const int p = gt & 63, idx = gt >> 6;
        const float lre = fminf(a.in[10][idx * 64 + p], -1e-4f), lim = a.in[11][idx * 64 + p], step = expf(a.in[12][idx]);
        const float mag = expf(lre * step), abr = mag * cosf(lim * step), abi = mag * sinf(lim * step);
        const float den = lre * lre + lim * lim, ir = lre / den, ii = -lim / den;
        const float nr = (abr - 1.f) * ir - abi * ii, ni = (abr - 1.f) * ii + abi * ir;
        unsigned char* t = ws + WS_S5T;
        ((float*)(t + S5_ABR))[gt] = abr; ((float*)(t + S5_ABI))[gt] = abi;
        float pr = abr, pi = abi;
#pragma unroll
        for (int s = 0; s < 6; ++s) { const float nr2 = pr * pr - pi * pi, ni2 = 2.f * pr * pi; pr = nr2; pi = ni2; }
        ((float*)(t + S5_A64R))[gt] = pr; ((float*)(t + S5_A64I))[gt] = pi;
        bf16_t* BBT = (bf16_t*)(t + S5_BBT); bf16_t* CT = (bf16_t*)(t + S5_CT);
        for (int m = 0; m < 16; ++m) { const float br = a.in[13][(size_t)(idx * 64 + p) * 16 + m], bi = a.in[14][(size_t)(idx * 64 + p) * 16 + m];
            BBT[(size_t)(idx * 128 + p) * 16 + m] = (bf16_t)f2bf(nr * br - ni * bi); BBT[(size_t)(idx * 128 + 64 + p) * 16 + m] = (bf16_t)f2bf(nr * bi + ni * br); }
        for (int n = 0; n < 16; ++n) { CT[(size_t)(idx * 16 + n) * 128 + p] = (bf16_t)f2bf(a.in[15][(size_t)(idx * 16 + n) * 64 + p]); CT[(size_t)(idx * 16 + n) * 128 + 64 + p] = (bf16_t)f2bf(-a.in[16][(size_t)(idx * 16 + n) * 64 + p]); }
    }
    float* RT = (float*)(ws + WS_ROPE);
    for (int e = gt; e < SEQ * 64; e += NGT) { const int t = e >> 6, j = e & 63; const float pos = (float)(j < 32 ? (t >> 6) : (t & 63));
        const float inv = powf(10000.f, -(float)(j & 31) / 32.f), ang = pos * inv; RT[2 * e] = cosf(ang); RT[2 * e + 1] = sinf(ang); }
}

__device__ __forceinline__ float wave_sum(float v) {
#pragma unroll
    for (int o = 1; o < 64; o <<= 1) v += __shfl_xor(v, o);
    return v;
}
__device__ __forceinline__ void phase_norm(const float* resL, const float* resC, const float* nw, const float* modl, int si, bf16_t* XN, int M, int lane, int wave) {
    const int gw = blockIdx.x * NWAVES + wave, NGW = gridDim.x * NWAVES;
    for (int row = gw; row < M; row += NGW) {
        const float* src = row < MLAT ? resL + (size_t)row * DM : resC + (size_t)(row - MLAT) * DM;
        const int mr = row < MLAT ? row / SEQ : 4;
        const float* sh = modl + (size_t)mr * MODW + si * DM; const float* sc = sh + DM;
        f32x4 v[8]; float ss = 0.f;
#pragma unroll
        for (int j = 0; j < 8; ++j) { v[j] = __builtin_nontemporal_load((const f32x4*)(src + (j * 64 + lane) * 4)); ss += (v[j][0] * v[j][0] + v[j][1] * v[j][1]) + (v[j][2] * v[j][2] + v[j][3] * v[j][3]); }
        const float rstd = rsqrtf(wave_sum(ss) * (1.f / DM) + EPSN);
#pragma unroll
        for (int j = 0; j < 8; ++j) { const int c = (j * 64 + lane) * 4; const f32x4 w = *(const f32x4*)(nw + c), s1 = *(const f32x4*)(sc + c), s0 = *(const f32x4*)(sh + c);
            f32x4 y = (v[j] * rstd) * w; y = y * (s1 + 1.f) + s0;
            u32x2 o; o.x = pk2(y[0], y[1]); o.y = pk2(y[2], y[3]); *(u32x2*)(XN + (size_t)row * DM + c) = o; }
    }
}
__device__ __forceinline__ void bias_gemv(const float* shiftbase, const bf16_t* Wt, int N, float* out, int ldo, LAS unsigned char* L, int tid, int lane, int wave) {
    LAS float* sh = (LAS float*)L;
    __syncthreads();
#pragma unroll 1
    for (int i = tid; i < 5 * DM; i += NTHR) sh[i] = shiftbase[(size_t)(i >> 11) * MODW + (i & 2047)];
    __syncthreads();
    const int gw = blockIdx.x * NWAVES + wave, NGW = gridDim.x * NWAVES, sub = lane >> 4, l16 = lane & 15;
#pragma unroll 1
    for (int n0 = gw * 4; n0 < N; n0 += NGW * 4) {
        const int n = n0 + sub;
        float s[5] = {0.f, 0.f, 0.f, 0.f, 0.f};
#pragma unroll 4
        for (int q = 0; q < 16; ++q) { const int k = q * 128 + l16 * 8; const u32x4 v = __builtin_nontemporal_load((const u32x4*)(Wt + (size_t)n * DM + k));
            const float w0 = bflo(v.x), w1 = bfhi(v.x), w2 = bflo(v.y), w3 = bfhi(v.y), w4 = bflo(v.z), w5 = bfhi(v.z), w6 = bflo(v.w), w7 = bfhi(v.w);
#pragma unroll
            for (int r = 0; r < 5; ++r) { const f32x4 sa = *(const LAS f32x4*)(sh + r * DM + k), sb = *(const LAS f32x4*)(sh + r * DM + k + 4);
                s[r] += (w0 * sa[0] + w1 * sa[1]) + (w2 * sa[2] + w3 * sa[3]) + (w4 * sb[0] + w5 * sb[1]) + (w6 * sb[2] + w7 * sb[3]); } }
#pragma unroll
        for (int r = 0; r < 5; ++r) { float t = s[r]; t += __shfl_xor(t, 1); t += __shfl_xor(t, 2); t += __shfl_xor(t, 4); t += __shfl_xor(t, 8);
            if (l16 == 0) out[(size_t)r * ldo + n] = t; }
    }
}
__device__ __forceinline__ void phase_final(const float* X, const float* nw, float* out, int lane, int wave) {
    const int gw = blockIdx.x * NWAVES + wave, NGW = gridDim.x * NWAVES;
    for (int row = gw; row < MLAT; row += NGW) {
        const float* src = X + (size_t)row * DM;
        f32x4 v[8]; float ss = 0.f;
#pragma unroll
        for (int j = 0; j < 8; ++j) { v[j] = __builtin_nontemporal_load((const f32x4*)(src + (j * 64 + lane) * 4)); ss += (v[j][0] * v[j][0] + v[j][1] * v[j][1]) + (v[j][2] * v[j][2] + v[j][3] * v[j][3]); }
        const float rstd = rsqrtf(wave_sum(ss) * (1.f / DM) + EPSN);
#pragma unroll
        for (int j = 0; j < 8; ++j) { const int c = (j * 64 + lane) * 4; const f32x4 w = *(const f32x4*)(nw + c); __builtin_nontemporal_store((v[j] * rstd) * w, (f32x4*)(out + (size_t)row * DM + c)); }
    }
}

constexpr int TS = 136;
constexpr int TILE_B = 128 * TS * 2;
constexpr int LA_ARR = 4 * TILE_B;
constexpr int AR_B = 0, AR_G = 256, AR_M = 512, AR_RS = 768, AR_N = 1024, AR_W = 1280, AR_KP = 1536, AR_MISC = 2048;

__device__ __forceinline__ bf16x8 frag_row(const LAS unsigned char* tile, int r0, int ks, int lane) {
    return *(const LAS bf16x8*)(tile + ((r0 + (lane & 15)) * TS + 32 * ks + 8 * (lane >> 4)) * 2);
}
__device__ __forceinline__ bf16x8 frag_tr(const LAS unsigned char* tile, int c0, int ks, int lane) {
    const int g = lane >> 4, q = (lane & 15) >> 2, p = lane & 3;
    const LAS unsigned char* a0 = tile + ((32 * ks + 8 * g + q) * TS + c0 + 4 * p) * 2;
    const s16x4 lo = __builtin_amdgcn_ds_read_tr16_b64_v4i16((LAS s16x4*)a0);
    const s16x4 hi = __builtin_amdgcn_ds_read_tr16_b64_v4i16((LAS s16x4*)(a0 + 4 * TS * 2));
    return (bf16x8){lo[0], lo[1], lo[2], lo[3], hi[0], hi[1], hi[2], hi[3]};
}
__device__ __forceinline__ void tile_copy(LAS unsigned char* tile, const bf16_t* src, int ld, int tid) {
#pragma unroll
    for (int i = 0; i < 4; ++i) { const int id = tid + NTHR * i, row = id >> 4, ch = id & 15;
        const u32x4 v = *(const u32x4*)(src + (size_t)row * ld + ch * 8);
        *(LAS u32x4*)(tile + (row * TS + ch * 8) * 2) = v; }
}
__device__ __forceinline__ void ld_pair(const bf16_t* rowp, int ch, bool rope, int t, const float* RT, float (&lo)[8], float (&hi)[8]) {
    const u32x4 a = *(const u32x4*)(rowp + ch * 8), b = *(const u32x4*)(rowp + 64 + ch * 8);
    lo[0] = bflo(a.x); lo[1] = bfhi(a.x); lo[2] = bflo(a.y); lo[3] = bfhi(a.y); lo[4] = bflo(a.z); lo[5] = bfhi(a.z); lo[6] = bflo(a.w); lo[7] = bfhi(a.w);
    hi[0] = bflo(b.x); hi[1] = bfhi(b.x); hi[2] = bflo(b.y); hi[3] = bfhi(b.y); hi[4] = bflo(b.z); hi[5] = bfhi(b.z); hi[6] = bflo(b.w); hi[7] = bfhi(b.w);
    if (rope) {
        const f32x4* cs = (const f32x4*)(RT + ((size_t)t * 64 + ch * 8) * 2);
#pragma unroll
        for (int q = 0; q < 4; ++q) { const f32x4 v = cs[q];
            { const float x1 = lo[2 * q], x2 = hi[2 * q]; lo[2 * q] = x1 * v[0] - x2 * v[1]; hi[2 * q] = x1 * v[1] + x2 * v[0]; }
            { const float x1 = lo[2 * q + 1], x2 = hi[2 * q + 1]; lo[2 * q + 1] = x1 * v[2] - x2 * v[3]; hi[2 * q + 1] = x1 * v[3] + x2 * v[2]; } }
    }
}
__device__ __forceinline__ void st8(LAS unsigned char* p, const float (&v)[8], float s) {
    u32x4 w; w.x = pk2(v[0] * s, v[1] * s); w.y = pk2(v[2] * s, v[3] * s); w.z = pk2(v[4] * s, v[5] * s); w.w = pk2(v[6] * s, v[7] * s);
    *(LAS u32x4*)p = w;
}
struct GateScan { float b0, b1, g0, g1, cm0, cm1, btot, gmax; int p0, p1; };
__device__ __forceinline__ GateScan gate_scan(int ty, int d, int lane, const float* gates, int rowbase, int h, float lgv, float ibv, float fbv) {
    GateScan r; const int i0 = 2 * lane, i1 = i0 + 1; r.p0 = d ? 127 - i0 : i0; r.p1 = d ? 127 - i1 : i1;
    float lf0 = lgv, lf1 = lgv, ii0 = 0.f, ii1 = 0.f;
    if (ty) { const float* g0p = gates + (size_t)(rowbase + r.p0) * 24 + d * 12 + h; const float* g1p = gates + (size_t)(rowbase + r.p1) * 24 + d * 12 + h;
        ii0 = g0p[0] + ibv; ii1 = g1p[0] + ibv; lf0 = logsigf_(g0p[6] + fbv); lf1 = logsigf_(g1p[6] + fbv); }
    const float s1 = lf0 + lf1; float inc = s1;
#pragma unroll
    for (int o = 1; o < 64; o <<= 1) { const float t = __shfl_up(inc, o); if (lane >= o) inc += t; }
    const float ex = inc - s1;
    r.b0 = ex + lf0; r.b1 = ex + s1; r.btot = __shfl(inc, 63);
    r.g0 = ii0 - r.b0; r.g1 = ii1 - r.b1;
    const float c1 = fmaxf(r.g0, r.g1); float mx = c1;
#pragma unroll
    for (int o = 1; o < 64; o <<= 1) { const float t = __shfl_up(mx, o); if (lane >= o) mx = fmaxf(mx, t); }
    float exm = __shfl_up(mx, 1); if (lane == 0) exm = -3.0e38f;
    r.cm0 = fmaxf(exm, r.g0); r.cm1 = fmaxf(exm, c1); r.gmax = __shfl(mx, 63);
    return r;
}

struct LaCtx { const Args* a; int l; bool last; };

__device__ __forceinline__ void la_phase_c(const Args& a, int l, LAS unsigned char* L, int task, int tid, int lane, int wave) {
    unsigned char* ws = a.ws;
    const int ty = task / 432, rem = task % 432, b = rem / 108, h = (rem % 108) / 18, pb = rem % 18;
    const int rowbase = pb_row(b, pb), colq = (ty ? COL_M : COL_R) + h * 128;
    const bf16_t* Ab = (const bf16_t*)(ws + WS_A);
    LAS float* AR = (LAS float*)(L + LA_ARR);
    const bool rope = (ty == 0 && pb >= 2);
    const float scale = 0.08838834764831845f;
    const int seq0 = ((ty * 4 + b) * 6 + h) * 2;
    if (wave < 2) {
        const int d = wave;
        const float lgv = logsigf_(a.in[20][(l * 2 + d) * 6 + h]), ibv = a.in[22][(l * 2 + d) * 6 + h], fbv = a.in[23][(l * 2 + d) * 6 + h];
        const GateScan s = gate_scan(ty, d, lane, (const float*)(ws + WS_GATES), rowbase, h, lgv, ibv, fbv);
        const float mloc = ty ? s.btot + s.gmax : 0.f;
        AR[AR_W + d * 128 + s.p0] = __expf(s.btot + s.g0 - mloc) * scale; AR[AR_W + d * 128 + s.p1] = __expf(s.btot + s.g1 - mloc) * scale;
        if (lane == 0) { float* SC = (float*)(ws + WS_SMALL + SM_SC) + (size_t)((seq0 + d) * NPB + pb) * 2; SC[0] = s.btot; SC[1] = mloc; }
        { float* GS = (float*)(ws + WS_GS) + (size_t)((seq0 + d) * NPB + pb) * 384;
          GS[s.p0] = s.b0; GS[s.p1] = s.b1; GS[128 + s.p0] = s.g0; GS[128 + s.p1] = s.g1; GS[256 + s.p0] = s.cm0; GS[256 + s.p1] = s.cm1; }
    }
    const float* RT = (const float*)(ws + WS_ROPE);
    float klo[2][8], khi[2][8];
#pragma unroll
    for (int i = 0; i < 2; ++i) { const int id = tid + NTHR * i, row = id >> 3, ch = id & 7;
        ld_pair(Ab + (size_t)(rowbase + row) * AW + colq + 768, ch, rope, (pb - 2) * 128 + row, RT, klo[i], khi[i]); }
    tile_copy(L + 2 * TILE_B, Ab + (size_t)rowbase * AW + colq + 1536, AW, tid);
    __syncthreads();
#pragma unroll
    for (int i = 0; i < 2; ++i) { const int id = tid + NTHR * i, row = id >> 3, ch = id & 7;
        const float w0 = AR[AR_W + row], w1 = AR[AR_W + 128 + row];
        st8(L + (row * TS + ch * 8) * 2, klo[i], w0); st8(L + (row * TS + 64 + ch * 8) * 2, khi[i], w0);
        st8(L + TILE_B + (row * TS + ch * 8) * 2, klo[i], w1); st8(L + TILE_B + (row * TS + 64 + ch * 8) * 2, khi[i], w1); }
    __syncthreads();
    const int c = lane & 15, g = lane >> 4;
    bf16_t* KV = (bf16_t*)(ws + WS_KV);
#pragma unroll
    for (int d = 0; d < 2; ++d) {
        f32x4 kv[8];
#pragma unroll
        for (int jt = 0; jt < 8; ++jt) kv[jt] = (f32x4){0.f, 0.f, 0.f, 0.f};
#pragma unroll
        for (int ks = 0; ks < 4; ++ks) { const bf16x8 bv = frag_tr(L + 2 * TILE_B, 16 * wave, ks, lane);
#pragma unroll
            for (int jt = 0; jt < 8; ++jt) { const bf16x8 ak = frag_tr(L + d * TILE_B, 16 * jt, ks, lane); kv[jt] = mfma16(ak, bv, kv[jt]); } }
        bf16_t* dst = KV + ((size_t)((seq0 + d) * NPB + pb) * 128 + 16 * wave + c) * 128 + 4 * g;
#pragma unroll
        for (int jt = 0; jt < 8; ++jt) { u32x2 o; o.x = pk2(kv[jt][0], kv[jt][1]); o.y = pk2(kv[jt][2], kv[jt][3]); *(u32x2*)(dst + 16 * jt) = o; }
    }
    if (ty) {
        const int dk = tid & 127, d = (tid >> 7) & 1, half = tid >> 8; float s = 0.f;
        const LAS bf16_t* T = (const LAS bf16_t*)(L + d * TILE_B);
        for (int p = half * 64; p < half * 64 + 64; ++p) s += bf1(T[p * TS + dk]);
        AR[AR_KP + (half * 2 + d) * 128 + dk] = s;
    }
    __syncthreads();
    if (ty && tid < 256) { const int dk = tid & 127, d = tid >> 7;
        ((float*)(ws + WS_SMALL + SM_KN))[(size_t)((seq0 + d) * NPB + pb) * 128 + dk] = AR[AR_KP + d * 128 + dk] + AR[AR_KP + (2 + d) * 128 + dk]; }
    __syncthreads();
}

__device__ __forceinline__ void la_phase_d(const Args& a, int tid) {
    unsigned char* ws = a.ws;
    const int gt = blockIdx.x * NTHR + tid, NGT = gridDim.x * NTHR;
    const float* SC = (const float*)(ws + WS_SMALL + SM_SC); float* MP = (float*)(ws + WS_SMALL + SM_MPREV);
    const bf16_t* KV = (const bf16_t*)(ws + WS_KV); bf16_t* CB = (bf16_t*)(ws + WS_CB);
#pragma unroll 1
    for (int it = gt; it < 96 * 4096; it += NGT) {
        const int seq = it >> 12, e4 = it & 4095, d = seq & 1, ty = seq >= 48;
        u32x2 kv[NPB]; float be[NPB], ml[NPB];
#pragma unroll
        for (int k = 0; k < NPB; ++k) { const int pb = seq_pb(d, k); const size_t o = (size_t)(seq * NPB + pb);
            kv[k] = __builtin_nontemporal_load((const u32x2*)(KV + o * 16384 + e4 * 4)); be[k] = SC[o * 2]; ml[k] = SC[o * 2 + 1]; }
        float c0 = 0.f, c1 = 0.f, c2 = 0.f, c3 = 0.f, m = 0.f;
#pragma unroll
        for (int k = 0; k < NPB; ++k) { const int pb = seq_pb(d, k); const size_t o = (size_t)(seq * NPB + pb);
            u32x2 w; w.x = pk2(c0, c1); w.y = pk2(c2, c3); *(u32x2*)(CB + o * 16384 + e4 * 4) = w;
            if (e4 == 0) MP[o] = m;
            const float mn = ty ? fmaxf(be[k] + m, ml[k]) : 0.f, al = __expf(be[k] + m - mn), bt = __expf(ml[k] - mn);
            c0 = al * c0 + bt * bflo(kv[k].x); c1 = al * c1 + bt * bfhi(kv[k].x); c2 = al * c2 + bt * bflo(kv[k].y); c3 = al * c3 + bt * bfhi(kv[k].y); m = mn; }
    }
    const float* KN = (const float*)(ws + WS_SMALL + SM_KN); float* NBF = (float*)(ws + WS_SMALL + SM_NBEF);
    for (int it = gt; it < 48 * 128; it += NGT) {
        const int seq = 48 + (it >> 7), dk = it & 127, d = seq & 1;
        float kn[NPB], be[NPB], ml[NPB];
#pragma unroll
        for (int k = 0; k < NPB; ++k) { const int pb = seq_pb(d, k); const size_t o = (size_t)(seq * NPB + pb); kn[k] = KN[o * 128 + dk]; be[k] = SC[o * 2]; ml[k] = SC[o * 2 + 1]; }
        float n = 0.f, m = 0.f;
#pragma unroll
        for (int k = 0; k < NPB; ++k) { const int pb = seq_pb(d, k); const size_t o = (size_t)(seq * NPB + pb);
            NBF[o * 128 + dk] = n;
            const float mn = fmaxf(be[k] + m, ml[k]), al = __expf(be[k] + m - mn), bt = __expf(ml[k] - mn);
            n = al * n + bt * kn[k]; m = mn; }
    }
}

__device__ __forceinline__ void unpack8(const u32x4 a, float (&v)[8]) { v[0] = bflo(a.x); v[1] = bfhi(a.x); v[2] = bflo(a.y); v[3] = bfhi(a.y); v[4] = bflo(a.z); v[5] = bfhi(a.z); v[6] = bflo(a.w); v[7] = bfhi(a.w); }
__device__ __forceinline__ void rope8(const f32x4 (&cs)[4], float (&lo)[8], float (&hi)[8]) {
#pragma unroll
    for (int q = 0; q < 4; ++q) { const f32x4 v = cs[q];
        { const float x1 = lo[2 * q], x2 = hi[2 * q]; lo[2 * q] = x1 * v[0] - x2 * v[1]; hi[2 * q] = x1 * v[1] + x2 * v[0]; }
        { const float x1 = lo[2 * q + 1], x2 = hi[2 * q + 1]; lo[2 * q + 1] = x1 * v[2] - x2 * v[3]; hi[2 * q + 1] = x1 * v[3] + x2 * v[2]; } }
}
__device__ __forceinline__ void la_phase_e(const Args& a, int l, LAS unsigned char* L, int task, int tid, int lane, int wave) {
    unsigned char* ws = a.ws;
    const int ty = task / 432, rem = task % 432, b = rem / 108, h = (rem % 108) / 18, pb = rem % 18;
    const int rowbase = pb_row(b, pb), colq = (ty ? COL_M : COL_R) + h * 128;
    const bf16_t* Ab = (const bf16_t*)(ws + WS_A);
    LAS float* AR = (LAS float*)(L + LA_ARR);
    const bool rope = (ty == 0 && pb >= 2);
    const float scale = 0.08838834764831845f;
    const int seq0 = ((ty * 4 + b) * 6 + h) * 2;
    const float* MP = (const float*)(ws + WS_SMALL + SM_MPREV);
    const float mp0 = ty ? MP[(size_t)(seq0 + 0) * NPB + pb] : 0.f, mp1 = ty ? MP[(size_t)(seq0 + 1) * NPB + pb] : 0.f;
    const float* RT = (const float*)(ws + WS_ROPE);
    const bf16_t* CB = (const bf16_t*)(ws + WS_CB);
    const int c = lane & 15, g = lane >> 4, p = 16 * wave + c;
    u32x4 ct1[4];
    const bf16_t* gp = Ab + (size_t)(rowbase + p) * AW + colq + 2304;
    u32x2 gvr[8];
#ifdef PROBE_LAE_LOADREP
#pragma unroll 1
    for (int rp_ = 0; rp_ < 2; ++rp_) {
#endif
    if (wave < 4) {
        const int d = tid >> 7, pp = tid & 127;
        const float* GS = (const float*)(ws + WS_GS) + (size_t)((seq0 + d) * NPB + pb) * 384;
        const float bb = GS[pp], gg = GS[128 + pp], cm = GS[256 + pp], mp = d ? mp1 : mp0;
        AR[AR_B + d * 128 + pp] = bb; AR[AR_G + d * 128 + pp] = gg; AR[AR_M + d * 128 + pp] = ty ? fmaxf(mp, cm) : -bb;
    }
    if (wave >= 4 && ty) {
        const int i = tid - 256, d = i >> 7, dk = i & 127;
        AR[AR_N + d * 128 + dk] = ((const float*)(ws + WS_SMALL + SM_NBEF))[(size_t)((seq0 + d) * NPB + pb) * 128 + dk];
    }
    if (wave >= 6) { const int i = tid - 384; AR[AR_W + i] = ((ty ? a.in[24] : a.in[21]) + (size_t)l * 768 + h * 128)[i]; }
#pragma unroll
    for (int i = 0; i < 2; ++i) { const int id = tid + NTHR * i, row = id >> 3, ch = id & 7; float lo[8], hi[8];
        const bf16_t* rp = Ab + (size_t)(rowbase + row) * AW + colq + ch * 8;
        const u32x4 qa = *(const u32x4*)rp, qb = *(const u32x4*)(rp + 64), ka = *(const u32x4*)(rp + 768), kb = *(const u32x4*)(rp + 768 + 64);
        f32x4 cs[4];
        if (rope) { const f32x4* cp = (const f32x4*)(RT + ((size_t)((pb - 2) * 128 + row) * 64 + ch * 8) * 2); cs[0] = cp[0]; cs[1] = cp[1]; cs[2] = cp[2]; cs[3] = cp[3]; }
        unpack8(qa, lo); unpack8(qb, hi); if (rope) rope8(cs, lo, hi);
        st8(L + (row * TS + ch * 8) * 2, lo, 1.f); st8(L + (row * TS + 64 + ch * 8) * 2, hi, 1.f);
        unpack8(ka, lo); unpack8(kb, hi); if (rope) rope8(cs, lo, hi);
        st8(L + TILE_B + (row * TS + ch * 8) * 2, lo, 1.f); st8(L + TILE_B + (row * TS + 64 + ch * 8) * 2, hi, 1.f); }
    __syncthreads();
#ifdef PROBE_LAE_LOADREP
    }
#endif
    u32x4 vreg[4], c0reg[4];
#pragma unroll
    for (int i = 0; i < 4; ++i) { const int id = tid + NTHR * i, row = id >> 4, ch = id & 15;
        vreg[i] = *(const u32x4*)(Ab + (size_t)(rowbase + row) * AW + colq + 1536 + ch * 8);
        c0reg[i] = *(const u32x4*)(CB + (size_t)((seq0 + 0) * NPB + pb) * 16384 + (size_t)row * 128 + ch * 8); }
    f32x4 s[8];
#pragma unroll
    for (int jt = 0; jt < 8; ++jt) s[jt] = (f32x4){0.f, 0.f, 0.f, 0.f};
#pragma unroll
    for (int ks = 0; ks < 4; ++ks) { const bf16x8 bq = frag_row(L, 16 * wave, ks, lane);
#pragma unroll
        for (int jt = 0; jt < 8; ++jt) { const bf16x8 ak = frag_row(L + TILE_B, 16 * jt, ks, lane); s[jt] = mfma16(ak, bq, s[jt]); } }
    float qn0 = 0.f, qn1 = 0.f;
    if (ty) {
        const LAS bf16_t* qr = (const LAS bf16_t*)L + p * TS + 32 * g;
#pragma unroll 8
        for (int j = 0; j < 32; ++j) { const float q = bf1(qr[j]); qn0 += q * AR[AR_N + 32 * g + j]; qn1 += q * AR[AR_N + 128 + 32 * g + j]; }
        qn0 += __shfl_xor(qn0, 16); qn0 += __shfl_xor(qn0, 32); qn1 += __shfl_xor(qn1, 16); qn1 += __shfl_xor(qn1, 32);
    }
    const float M0 = AR[AR_M + p], M1 = AR[AR_M + 128 + p];
    f32x4 P1[8]; float rs0 = 0.f, rs1 = 0.f;
#pragma unroll
    for (int jt = 0; jt < 8; ++jt) {
        const f32x4 g0v = *(const LAS f32x4*)(AR + AR_G + 16 * jt + 4 * g), g1v = *(const LAS f32x4*)(AR + AR_G + 128 + 16 * jt + 4 * g);
#pragma unroll
        for (int e = 0; e < 4; ++e) { const int pp = 16 * jt + 4 * g + e; const float sv = s[jt][e] * scale;
            const float w0 = pp <= p ? __expf(g0v[e] - M0) : 0.f, w1 = pp >= p ? __expf(g1v[e] - M1) : 0.f;
            const float x0 = sv * w0, x1 = sv * w1; s[jt][e] = x0; P1[jt][e] = x1; rs0 += x0; rs1 += x1; }
    }
    rs0 += __shfl_xor(rs0, 16); rs0 += __shfl_xor(rs0, 32); rs1 += __shfl_xor(rs1, 16); rs1 += __shfl_xor(rs1, 32);
    float idn0 = 1.f, idn1 = 1.f, a0 = __expf(mp0 - M0), a1 = __expf(mp1 - M1);
    if (ty) {
        const float den0 = rs0 + a0 * qn0, den1 = rs1 + a1 * qn1;
        idn0 = __builtin_amdgcn_rcpf(fmaxf(fabsf(den0), __expf(-(AR[AR_B + p] + M0)))); idn1 = __builtin_amdgcn_rcpf(fmaxf(fabsf(den1), __expf(-(AR[AR_B + 128 + p] + M1))));
    }
#pragma unroll
    for (int i = 0; i < 4; ++i) { const int id = tid + NTHR * i; const int off = ((id >> 4) * TS + (id & 15) * 8) * 2;
        *(LAS u32x4*)(L + 2 * TILE_B + off) = vreg[i]; *(LAS u32x4*)(L + 3 * TILE_B + off) = c0reg[i]; }
    __syncthreads();
#pragma unroll
    for (int jt = 0; jt < 8; ++jt) { const f32x4 v = s[jt] * idn0 + P1[jt] * idn1; u32x2 o; o.x = pk2(v[0], v[1]); o.y = pk2(v[2], v[3]);
        *(LAS u32x2*)(L + TILE_B + (p * TS + 16 * jt + 4 * g) * 2) = o; }
    if (g == 0) { AR[AR_RS + p] = a0 * idn0; AR[AR_RS + 128 + p] = a1 * idn1; }
    __syncthreads();
#pragma unroll
    for (int i = 0; i < 4; ++i) { const int id = tid + NTHR * i; ct1[i] = *(const u32x4*)(CB + (size_t)((seq0 + 1) * NPB + pb) * 16384 + (size_t)(id >> 4) * 128 + (id & 15) * 8); }
#pragma unroll
    for (int jt = 0; jt < 8; ++jt) gvr[jt] = *(const u32x2*)(gp + 16 * jt + 4 * g);
    f32x4 o[8];
#pragma unroll
    for (int jt = 0; jt < 8; ++jt) o[jt] = (f32x4){0.f, 0.f, 0.f, 0.f};
#pragma unroll
    for (int ks = 0; ks < 4; ++ks) { const bf16x8 bs = frag_row(L + TILE_B, 16 * wave, ks, lane);
#pragma unroll
        for (int jt = 0; jt < 8; ++jt) { const bf16x8 av = frag_tr(L + 2 * TILE_B, 16 * jt, ks, lane); o[jt] = mfma16(av, bs, o[jt]); } }
    __syncthreads();
#pragma unroll
    for (int d = 0; d < 2; ++d) {
        if (d == 1) {
#pragma unroll
            for (int i = 0; i < 4; ++i) { const int id = tid + NTHR * i; *(LAS u32x4*)(L + 2 * TILE_B + ((id >> 4) * TS + (id & 15) * 8) * 2) = ct1[i]; } }
        { const int r = 16 * wave + (lane >> 2), cc = (lane & 3) * 32; const float rsv = AR[AR_RS + d * 128 + r];
#pragma unroll
            for (int q = 0; q < 4; ++q) { const u32x4 v = *(const LAS u32x4*)(L + (r * TS + cc + 8 * q) * 2);
                u32x4 w; w.x = pk2(bflo(v.x) * rsv, bfhi(v.x) * rsv); w.y = pk2(bflo(v.y) * rsv, bfhi(v.y) * rsv); w.z = pk2(bflo(v.z) * rsv, bfhi(v.z) * rsv); w.w = pk2(bflo(v.w) * rsv, bfhi(v.w) * rsv);
                *(LAS u32x4*)(L + TILE_B + (r * TS + cc + 8 * q) * 2) = w; } }
        __syncthreads();
        const LAS unsigned char* CT = L + (d ? 2 : 3) * TILE_B;
#pragma unroll
        for (int ks = 0; ks < 4; ++ks) { const bf16x8 bq = frag_row(L + TILE_B, 16 * wave, ks, lane);
#pragma unroll
            for (int jt = 0; jt < 8; ++jt) { const bf16x8 ac = frag_row(CT, 16 * jt, ks, lane); o[jt] = mfma16(ac, bq, o[jt]); } }
        __syncthreads();
    }
    float sum = 0.f;
#pragma unroll
    for (int jt = 0; jt < 8; ++jt) sum += (o[jt][0] + o[jt][1]) + (o[jt][2] + o[jt][3]);
    sum += __shfl_xor(sum, 16); sum += __shfl_xor(sum, 32);
    const float mean = ty ? 0.f : sum * (1.f / 128.f);
    float sq = 0.f;
#pragma unroll
    for (int jt = 0; jt < 8; ++jt) { o[jt] = o[jt] - mean; sq += (o[jt][0] * o[jt][0] + o[jt][1] * o[jt][1]) + (o[jt][2] * o[jt][2] + o[jt][3] * o[jt][3]); }
    sq += __shfl_xor(sq, 16); sq += __shfl_xor(sq, 32);
    const float rstd = rsqrtf(sq * (1.f / 128.f) + EPSN);
    bf16_t* yp = (bf16_t*)(ws + WS_Y) + (size_t)(rowbase + p) * DM + 512 + ty * 768 + h * 128;
#pragma unroll
    for (int jt = 0; jt < 8; ++jt) { const int v0 = 16 * jt + 4 * g; const u32x2 gv = gvr[jt]; const f32x4 w = *(const LAS f32x4*)(AR + AR_W + v0);
        float gt4[4] = {bflo(gv.x), bfhi(gv.x), bflo(gv.y), bfhi(gv.y)}; float y[4];
#pragma unroll
        for (int e = 0; e < 4; ++e) { const float sg = sigmoidf_(gt4[e]); const float act = ty ? sg : gt4[e] * sg; y[e] = o[jt][e] * rstd * w[e] * act; }
        u32x2 ov; ov.x = pk2(y[0], y[1]); ov.y = pk2(y[2], y[3]); *(u32x2*)(yp + v0) = ov; }
}

constexpr int S5_WLDS = 12800;
template <bool FULL>
__device__ __forceinline__ void s5_dir(const Args& a, int l, int b, int g, int sc, int d, LAS unsigned char* W, int lane, const bf16x8 (&afr)[4], f32x4 (&yacc)[4]) {
    unsigned char* ws = a.ws; const unsigned char* T = ws + WS_S5T;
    const int idx = (l * 2 + d) * 32 + g, c = lane & 15, q = lane >> 4;
    LAS float* BU = (LAS float*)W; LAS bf16_t* XS = (LAS bf16_t*)(W + 8448);
    const float abr = ((const float*)(T + S5_ABR))[idx * 64 + lane], abi = ((const float*)(T + S5_ABI))[idx * 64 + lane];
    bf16x8 bfr[8];
#pragma unroll
    for (int ct = 0; ct < 8; ++ct) { bfr[ct] = (bf16x8){0, 0, 0, 0, 0, 0, 0, 0};
        if (q < 2) bfr[ct] = *(const bf16x8*)((const bf16_t*)(T + S5_BBT) + (size_t)(idx * 128 + 16 * ct + c) * 16 + 8 * q); }
    bf16x8 cfr[4];
    if (FULL) {
#pragma unroll
        for (int ks = 0; ks < 4; ++ks) cfr[ks] = *(const bf16x8*)((const bf16_t*)(T + S5_CT) + (size_t)(idx * 16 + c) * 128 + 32 * ks + 8 * q);
    }
    float xr = 0.f, xi = 0.f;
    if (FULL) { const float* XI = (const float*)(ws + WS_XIN) + (size_t)(((b * 32 + g) * 2 + d) * NSC + sc) * 128; xr = XI[lane]; xi = XI[64 + lane]; }
#pragma unroll
    for (int sub = 0; sub < 4; ++sub) {
        const int sb = d ? 3 - sub : sub;
        const bf16x8 af = afr[sb];
#pragma unroll
        for (int ct = 0; ct < 8; ++ct) { const f32x4 r = mfma16(af, bfr[ct], (f32x4){0.f, 0.f, 0.f, 0.f});
#pragma unroll
            for (int j = 0; j < 4; ++j) BU[(4 * q + j) * 132 + 16 * ct + c] = r[j]; }
        asm volatile("s_waitcnt lgkmcnt(0)" ::: "memory");
#pragma unroll
        for (int i = 0; i < 16; ++i) { const int t = d ? 15 - i : i;
            const float re = BU[t * 132 + lane], im = BU[t * 132 + 64 + lane];
            const float nr = abr * xr - abi * xi + re, ni = abr * xi + abi * xr + im; xr = nr; xi = ni;
            if (FULL) { const unsigned pk = pk2(xr, xi); XS[t * 136 + lane] = (bf16_t)(pk & 0xffffu); XS[t * 136 + 64 + lane] = (bf16_t)(pk >> 16); } }
        asm volatile("s_waitcnt lgkmcnt(0)" ::: "memory");
        if (FULL) {
#pragma unroll
            for (int ks = 0; ks < 4; ++ks) { const bf16x8 xa = *(const LAS bf16x8*)(XS + c * 136 + 32 * ks + 8 * q); yacc[sb] = mfma16(xa, cfr[ks], yacc[sb]); }
            asm volatile("s_waitcnt lgkmcnt(0)" ::: "memory");
        }
    }
    if (!FULL) { float* ES = (float*)(ws + WS_ES) + (size_t)(((b * 32 + g) * 2 + d) * NSC + sc) * 128; ES[lane] = xr; ES[64 + lane] = xi; }
}
__device__ __forceinline__ void s5_load_af(const Args& a, int b, int g, int sc, int lane, bf16x8 (&afr)[4]) {
    const int c = lane & 15, q = lane >> 4, rowbase = sc_row(b, sc); const bf16_t* Ab = (const bf16_t*)(a.ws + WS_A);
#pragma unroll
    for (int sb = 0; sb < 4; ++sb) { afr[sb] = (bf16x8){0, 0, 0, 0, 0, 0, 0, 0};
        if (q < 2) afr[sb] = *(const bf16x8*)(Ab + (size_t)(rowbase + 16 * sb + c) * AW + g * 16 + 8 * q); }
}
__device__ __forceinline__ float gelu_tanh(float y) { const float u = 0.7978845608028654f * (y + 0.044715f * y * y * y); const float e = __expf(2.f * u); const float t = 1.f - 2.f * __builtin_amdgcn_rcpf(e + 1.f); return 0.5f * y * (1.f + t); }
__device__ __forceinline__ void s5_phase_c(const Args& a, int l, LAS unsigned char* L, int wt, int lane, int wave) {
    const int d = wt & 1, r = wt >> 1, sc = r % NSC, g = (r / NSC) & 31, b = r / (NSC * 32);
    f32x4 dummy[4]; bf16x8 afr[4]; s5_load_af(a, b, g, sc, lane, afr);
    if (d) s5_dir<false>(a, l, b, g, sc, 1, L + wave * S5_WLDS, lane, afr, dummy); else s5_dir<false>(a, l, b, g, sc, 0, L + wave * S5_WLDS, lane, afr, dummy);
}
__device__ __forceinline__ void s5_phase_e(const Args& a, int l, bool last, LAS unsigned char* L, int wt, int lane, int wave) {
    const int sc = wt % NSC, g = (wt / NSC) & 31, b = wt / (NSC * 32);
    if (last && sc < 4) return;
    f32x4 yacc[4];
#pragma unroll
    for (int i = 0; i < 4; ++i) yacc[i] = (f32x4){0.f, 0.f, 0.f, 0.f};
    const int c = lane & 15, q = lane >> 4, rowbase = sc_row(b, sc);
    const bf16_t* Ab = (const bf16_t*)(a.ws + WS_A); bf16_t* G = (bf16_t*)(a.ws + WS_G);
    bf16x8 afr[4]; s5_load_af(a, b, g, sc, lane, afr);
    bf16_t uu[16];
#pragma unroll
    for (int sb = 0; sb < 4; ++sb)
#pragma unroll
        for (int j = 0; j < 4; ++j) uu[sb * 4 + j] = Ab[(size_t)(rowbase + 16 * sb + 4 * q + j) * AW + g * 16 + c];
    const float dsk = a.in[17][(size_t)l * 512 + g * 16 + c];
    s5_dir<true>(a, l, b, g, sc, 0, L + wave * S5_WLDS, lane, afr, yacc);
    s5_dir<true>(a, l, b, g, sc, 1, L + wave * S5_WLDS, lane, afr, yacc);
#pragma unroll
    for (int sb = 0; sb < 4; ++sb)
#pragma unroll
        for (int j = 0; j < 4; ++j) { const int row = rowbase + 16 * sb + 4 * q + j;
            const float y = yacc[sb][j] + dsk * bf1(uu[sb * 4 + j]);
            G[(size_t)row * 512 + g * 16 + c] = (bf16_t)(pk2(gelu_tanh(y), 0.f) & 0xffffu); }
}
__device__ __forceinline__ void s5_phase_d(const Args& a, int l, int tid) {
    unsigned char* ws = a.ws; const unsigned char* T = ws + WS_S5T;
    if (tid >= 64) return;
    for (int sq = blockIdx.x; sq < 256; sq += gridDim.x) {
        const int p = tid, d = sq & 1, g = (sq >> 1) & 31, idx = (l * 2 + d) * 32 + g;
        const float ar = ((const float*)(T + S5_A64R))[idx * 64 + p], ai = ((const float*)(T + S5_A64I))[idx * 64 + p];
        const float* ES = (const float*)(ws + WS_ES) + (size_t)sq * NSC * 128; float* XI = (float*)(ws + WS_XIN) + (size_t)sq * NSC * 128;
        float er[NSC], ei[NSC];
#pragma unroll
        for (int k = 0; k < NSC; ++k) { const int sc = seq_sc(d, k); er[k] = ES[sc * 128 + p]; ei[k] = ES[sc * 128 + 64 + p]; }
        float xr = 0.f, xi = 0.f;
#pragma unroll
        for (int k = 0; k < NSC; ++k) { const int sc = seq_sc(d, k);
            XI[sc * 128 + p] = xr; XI[sc * 128 + 64 + p] = xi;
            const float nr = ar * xr - ai * xi + er[k], ni = ar * xi + ai * xr + ei[k]; xr = nr; xi = ni; }
    }
}

#define XB_TMO      128
#define XB_XCNT(j)  (256  + 64 * (j))
#define XB_XSUB(j)  (1280 + 64 * (j))
#define XB_XGEN(j)  (2304 + 64 * (j))
#define XB_TOP      3328
#define XB_TOPGEN   3392
#define XCD_BAR_WORDS 3456
#define XB_SPIN_CAP (1u << 18)

__device__ __forceinline__ unsigned xb_ld(unsigned* p)              { return __hip_atomic_load(p, __ATOMIC_RELAXED, __HIP_MEMORY_SCOPE_AGENT); }
__device__ __forceinline__ unsigned xb_add(unsigned* p, unsigned v) { return __hip_atomic_fetch_add(p, v, __ATOMIC_RELAXED, __HIP_MEMORY_SCOPE_AGENT); }
__device__ __forceinline__ unsigned xb_xcc_id() { return (unsigned)__builtin_amdgcn_s_getreg((3 << 11) | 20) & 0xFu; }
#define XB_SPIN(cond, bar) do { unsigned _sp = 0; while (cond) { __builtin_amdgcn_s_sleep(1); \
    if ((++_sp & 255u) == 0u) { if (xb_ld(&(bar)[XB_TMO])) break; if (_sp > XB_SPIN_CAP) { atomicAdd(&(bar)[XB_TMO], 1u); break; } } } } while (0)

struct XcdBarrier {
    unsigned* bar; unsigned x;
    volatile LAS unsigned* st;
};

__device__ __forceinline__ XcdBarrier xcd_barrier_post(unsigned* bar, volatile LAS unsigned* st) {
    XcdBarrier b; b.bar = bar; b.x = xb_xcc_id(); b.st = st;
    if (threadIdx.x == 0) (void)xb_add(&bar[XB_XCNT(b.x)], 1u);
    return b;
}
__device__ __forceinline__ void xcd_barrier_complete(unsigned* bar, unsigned x, unsigned& nloc, unsigned& nx) {
    const unsigned G = gridDim.x * gridDim.y * gridDim.z;
    unsigned sum, cnt, mine, sp = 0u;
    for (;;) {
        sum = 0u; cnt = 0u; mine = 0u;
#pragma unroll
        for (unsigned j = 0; j < 16; ++j) { const unsigned c = xb_ld(&bar[XB_XCNT(j)]); sum += c; cnt += (c > 0u) ? 1u : 0u; mine = (j == x) ? c : mine; }
        if (sum == G) break;
        __builtin_amdgcn_s_sleep(1);
        if ((++sp & 255u) == 0u) { if (xb_ld(&bar[XB_TMO])) break; if (sp > XB_SPIN_CAP) { atomicAdd(&bar[XB_TMO], 1u); break; } }
    }
    nloc = mine > 0u ? mine : 1u; nx = cnt > 0u ? cnt : 1u;
}

__device__ __forceinline__ void xcd_barrier(const XcdBarrier& b) {
    asm volatile("s_waitcnt vmcnt(0)" ::: "memory");
    __syncthreads();
    if (threadIdx.x == 0) {
        unsigned* bar = b.bar;
        __builtin_amdgcn_s_waitcnt(0);
        unsigned nloc = b.st[0], nx = b.st[1];
        if (nloc == 0u) { xcd_barrier_complete(bar, b.x, nloc, nx); b.st[0] = nloc; b.st[1] = nx; }
        const unsigned old = xb_add(&bar[XB_XSUB(b.x)], 1u);
        const unsigned gen = old / nloc;
        if (old + 1u == (gen + 1u) * nloc) {
            __builtin_amdgcn_fence(__ATOMIC_RELEASE, "agent");
            asm volatile("s_waitcnt vmcnt(0)" ::: "memory");
            const unsigned og = xb_add(&bar[XB_TOP], 1u);
            const unsigned tg = og / nx;
            if (og + 1u == (tg + 1u) * nx) xb_add(&bar[XB_TOPGEN], 1u);
            else XB_SPIN(xb_ld(&bar[XB_TOPGEN]) == tg, bar);
            __builtin_amdgcn_fence(__ATOMIC_ACQUIRE, "agent");
            xb_add(&bar[XB_XGEN(b.x)], 1u);
            asm volatile("s_waitcnt vmcnt(0)" ::: "memory");
        } else {
            XB_SPIN(xb_ld(&bar[XB_XGEN(b.x)]) == gen, bar);
            __builtin_amdgcn_fence(__ATOMIC_ACQUIRE, "agent");
            asm volatile("s_waitcnt vmcnt(0)" ::: "memory");
        }
    }
    __syncthreads();
}

constexpr int PH_L0 = 1, PH_PER_L = 10, PH_FINAL = 21, N_PHASES = 22;

struct SliceOrder {
    pg8::StaticOrder base; int full, R, S, Kr, c;
    __device__ bool next(int i, pg8::Unit& u) const { if (i != 0) return false; const int t = c / S; if (t >= R) return false; base.map(full + t, u); u.k0 = (c % S) * Kr; return true; }
    __device__ __forceinline__ void a_ready(const pg8::Unit&) const {}
    __device__ __forceinline__ void done(const pg8::Unit&) const {}
};
template <class Epi>
__device__ __forceinline__ void run_gemm(LAS unsigned char* L, const bf16_t* A, const bf16_t* Bt, int M, int N, int K, const Epi& E) {
    pg8::Gemm g{A, Bt, M, N, K, K}; pg8::StaticOrder S; S.init(M, N, (int)gridDim.x, (int)blockIdx.x);
#ifndef NO_GEMM
    pg8::gemm_phase<Epi, pg8::StaticOrder, true, true>((PG8_LAS unsigned char*)L, g, S, E);
#endif
}
struct EpiPart {
    static constexpr bool PERM = true, AFTER_DRAIN = false;
    float* P;
    __device__ __forceinline__ void operator()(const f32x4 (&acc)[2][2][4][2], const pg8::Unit& u, int wr, int wc, int fr, int fq) const {
        const int r0 = wr * 64 + fr, c0 = wc * 32 + 8 * fq;
#pragma unroll
        for (int ai = 0; ai < 2; ++ai)
#pragma unroll
            for (int m = 0; m < 4; ++m) { float* dst = P + (size_t)(r0 + ai * 128 + m * 16) * 256 + c0;
#pragma unroll
                for (int bj = 0; bj < 2; ++bj)
#pragma unroll
                    for (int n = 0; n < 2; ++n) *(f32x4*)(dst + bj * 128 + 4 * n) = acc[ai][bj][m][n]; }
    }
};
__device__ __forceinline__ void run_gemm_res(LAS unsigned char* L, const bf16_t* A, const bf16_t* Bt, int M, int N, int K, const EpiRes& E, float* PART, const XcdBarrier& xbar) {
    const int G = (int)gridDim.x, nwg = (M / 256) * (N / 256), full = (nwg / G) * G, R = nwg - full;
    int S = R > 0 ? G / R : 0; while (S > 1 && (K % (S * 128) != 0 || K / S < 256 || (256 % S) != 0)) --S;
    pg8::StaticOrder So; So.init(M, N, G, (int)blockIdx.x);
    if (S < 2 || full == 0) { pg8::Gemm g{A, Bt, M, N, K, K}; pg8::gemm_phase<EpiRes, pg8::StaticOrder, true, true>((PG8_LAS unsigned char*)L, g, So, E); return; }
    So.limit = full;
    { pg8::Gemm g{A, Bt, M, N, K, K}; pg8::gemm_phase<EpiRes, pg8::StaticOrder, true, true>((PG8_LAS unsigned char*)L, g, So, E); }
    const int c = (int)blockIdx.x, t = c / S, s = c % S;
    SliceOrder Ss; Ss.base = So; Ss.full = full; Ss.R = R; Ss.S = S; Ss.Kr = K / S; Ss.c = c;
    EpiPart EP{PART + ((size_t)(s * R + t) << 16)};
    { pg8::Gemm g{A, Bt, M, N, K / S, K}; pg8::gemm_phase<EpiPart, SliceOrder, true, true>((PG8_LAS unsigned char*)L, g, Ss, EP); }
    xcd_barrier(xbar);
    if (t < R) {
        pg8::Unit u; So.map(full + t, u);
        const int rows_per = 256 / S, mr = u.pm < 32 ? (u.pm >> 3) : 4; const int tid = threadIdx.x;
        for (int e = tid; e < rows_per * 64; e += NTHR) { const int rt = s * rows_per + (e >> 6), c4 = (e & 63) * 4, row = u.pm * 256 + rt, col = u.pn * 256 + c4;
            f32x4 sum = (f32x4){0.f, 0.f, 0.f, 0.f};
#pragma unroll 8
            for (int s2 = 0; s2 < S; ++s2) sum += __builtin_nontemporal_load((const f32x4*)(PART + ((size_t)(s2 * R + t) << 16) + rt * 256 + c4));
            const f32x4 g = *(const f32x4*)(E.modv + (size_t)mr * MODW + col);
            const float* src = (row < MLAT ? E.resL + (size_t)row * DM : E.resC + (size_t)(row - MLAT) * DM) + col;
            const f32x4 xv = __builtin_nontemporal_load((const f32x4*)src) + g * sum;
            *(f32x4*)(E.X + (size_t)row * DM + col) = xv;
            if (E.XS) { const f32x4 cw = *(const f32x4*)(E.nw + col) * (*(const f32x4*)(E.scv + (size_t)mr * MODW + col) + 1.f), y = xv * cw;
                u32x2 w; w.x = pk2(y[0], y[1]); w.y = pk2(y[2], y[3]); *(u32x2*)(E.XS + (size_t)row * DM + col) = w;
                const float ss = wave_sum((xv[0] * xv[0] + xv[1] * xv[1]) + (xv[2] * xv[2] + xv[3] * xv[3]));
                if ((tid & 63) == 0) __hip_atomic_fetch_add(E.rss + row, ss, __ATOMIC_RELAXED, __HIP_MEMORY_SCOPE_AGENT); } }
    }
}

__global__ void __launch_bounds__(NTHR, 2) fwd_kernel(Args a) {
    extern __shared__ __attribute__((aligned(16))) unsigned char lds_raw[];
    LAS unsigned char* L = (LAS unsigned char*)lds_raw;
    cg::grid_group grid = cg::this_grid();
    const int G = gridDim.x;
    unsigned char* ws = a.ws;
    if (threadIdx.x < 8) ((LAS unsigned*)(L + XB_LDS_OFF))[threadIdx.x] = 0u;
    __syncthreads();
    XcdBarrier xbar = xcd_barrier_post((unsigned*)(ws + WS_CTL), (volatile LAS unsigned*)(L + XB_LDS_OFF));
#define RUN(k) (a.ph_lo <= (k) && (k) < a.ph_hi)
#ifndef MK_COOP_SYNC0
#define MK_COOP_SYNC0 0
#endif
#define SEAM(k) do { if (RUN(k) && RUN((k) + 1)) { if (MK_COOP_SYNC0 && (k) == 0) grid.sync(); else xcd_barrier(xbar); } } while (0)
#define FRESH() int tid = threadIdx.x; asm volatile("" : "+v"(tid)); const int lane = tid & 63, wave = __builtin_amdgcn_readfirstlane(tid >> 6); int l = l_; asm volatile("" : "+s"(l)); int Gl = gridDim.x; asm volatile("" : "+s"(Gl)); (void)lane; (void)wave; (void)l; (void)Gl

    #ifndef NO_P0
    if (RUN(0)) { const int l_ = 0; FRESH(); phase_p0(a, L, tid, lane, wave); }
#ifdef PROBE_DUP_P0
    __syncthreads();
    if (RUN(0)) { const int l_ = 0; FRESH(); phase_p0(a, L, tid, lane, wave); }
#endif
#endif
    SEAM(0);
    float* X = (float*)(ws + WS_X); bf16_t* XN = (bf16_t*)(ws + WS_XN); bf16_t* Y = (bf16_t*)(ws + WS_Y); bf16_t* Ab = (bf16_t*)(ws + WS_A);
    const float* MOD = (const float*)(ws + WS_MOD);
#pragma unroll 1
    for (int l_ = 0; l_ < 2; ++l_) {
        const int ph = PH_L0 + PH_PER_L * l_;
#define LAYER_VARS() FRESH(); const bool last = (l == 1); const float* resL = l == 0 ? a.in[0] : X; const float* resC = l == 0 ? a.in[2] : X + (size_t)MLAT * DM; const float* modl = MOD + (size_t)l * 5 * MODW; const int Mo = last ? MLAT : MTOT; (void)last; (void)resL; (void)resC; (void)modl; (void)Mo
        if (RUN(ph + 0) && l_ == 0) { LAYER_VARS(); phase_norm(resL, resC, a.in[6] + (size_t)l * DM, modl, 0, XN, MTOT, lane, wave);
            float* FU = (float*)(ws + WS_FUSE);
#pragma unroll 1
            for (int i = blockIdx.x * NTHR + tid; i < 3 * MTOT; i += Gl * NTHR) ((float*)(ws + WS_FUSE + FU_RSS))[i] = 0.f;
            bias_gemv(MOD + 3 * DM, (const bf16_t*)(ws + WS_WFF1), DFF, (float*)(ws + WS_FUSE + FU_BIAS2), DFF, L, tid, lane, wave);
            bias_gemv(MOD + (size_t)5 * MODW + 3 * DM, (const bf16_t*)(ws + WS_WFF1 + 32 * MiB), DFF, (float*)(ws + WS_FUSE + FU_BIAS2) + 5 * DFF, DFF, L, tid, lane, wave);
            bias_gemv(MOD + (size_t)5 * MODW, (const bf16_t*)(ws + WS_WIN + 27 * MiB), INWP, (float*)(ws + WS_FUSE + FU_BIAS1), INWP, L, tid, lane, wave); (void)FU; }
        if (l_ == 0) SEAM(ph + 0);
        if (RUN(ph + 1)) { LAYER_VARS(); EpiIn E{Ab, (float*)(ws + WS_GATES), l == 0 ? (const float*)nullptr : (const float*)(ws + WS_FUSE + FU_RSS) + MTOT, (const float*)(ws + WS_FUSE + FU_BIAS1)}; run_gemm(L, XN, (const bf16_t*)(ws + WS_WIN + (size_t)l * 27 * MiB), MTOT, INWP, DM, E); }
#ifdef PROBE_DUP_GB
        if (RUN(ph + 1)) { __syncthreads(); LAYER_VARS(); EpiIn E{Ab, (float*)(ws + WS_GATES), l == 0 ? (const float*)nullptr : (const float*)(ws + WS_FUSE + FU_RSS) + MTOT, (const float*)(ws + WS_FUSE + FU_BIAS1)}; run_gemm(L, XN, (const bf16_t*)(ws + WS_WIN + (size_t)l * 27 * MiB), MTOT, INWP, DM, E); }
#endif
        SEAM(ph + 1);
#ifdef PROBE_DUP_MIX
        for (int rep_ = 0; rep_ < 2; ++rep_) {
#endif
        if (RUN(ph + 2)) { LAYER_VARS();
            if (blockIdx.x & 1) {
                for (int j = Gl - 1 - (int)blockIdx.x; j < 1152; j += Gl) s5_phase_c(a, l, L, j * 8 + wave, lane, wave);
                __syncthreads();
                for (int t = blockIdx.x; t < 864; t += Gl) la_phase_c(a, l, L, t, tid, lane, wave);
            } else {
                for (int t = blockIdx.x; t < 864; t += Gl) la_phase_c(a, l, L, t, tid, lane, wave);
                __syncthreads();
                for (int j = Gl - 1 - (int)blockIdx.x; j < 1152; j += Gl) s5_phase_c(a, l, L, j * 8 + wave, lane, wave);
            }
        }
        SEAM(ph + 2);
        #ifndef NO_D
        if (RUN(ph + 3)) { LAYER_VARS(); la_phase_d(a, tid); s5_phase_d(a, l, tid); }
#ifdef PROBE_DUP_D
        if (RUN(ph + 3)) { xcd_barrier(xbar); LAYER_VARS(); la_phase_d(a, tid); s5_phase_d(a, l, tid); }
#endif
#endif
        SEAM(ph + 3);
        if (RUN(ph + 4)) { LAYER_VARS();
            if (blockIdx.x & 1) {
                for (int j = Gl - 1 - (int)blockIdx.x; j < 576; j += Gl) s5_phase_e(a, l, last, L, j * 8 + wave, lane, wave);
                __syncthreads();
                for (int t = blockIdx.x; t < 864; t += Gl) { if (last && (t % 18) < 2) continue; la_phase_e(a, l, L, t, tid, lane, wave); __syncthreads(); }
            } else {
                for (int t = blockIdx.x; t < 864; t += Gl) { if (last && (t % 18) < 2) continue; la_phase_e(a, l, L, t, tid, lane, wave); __syncthreads(); }
                __syncthreads();
                for (int j = Gl - 1 - (int)blockIdx.x; j < 576; j += Gl) s5_phase_e(a, l, last, L, j * 8 + wave, lane, wave);
            }
            __syncthreads();
        }
        SEAM(ph + 4);
#ifdef PROBE_DUP_MIX
        }
#endif
        if (RUN(ph + 5)) { LAYER_VARS(); EpiGlu E{Y, a.in[19] + (size_t)l * 1024}; run_gemm(L, (const bf16_t*)(ws + WS_G), (const bf16_t*)(ws + WS_WGLU + (size_t)l * 1 * MiB), Mo, 1024, 512, E); }
        SEAM(ph + 5);
        if (RUN(ph + 6)) { LAYER_VARS(); EpiRes E{X, resL, resC, modl + 2 * DM, XN, a.in[7] + (size_t)l * DM, modl + 4 * DM, (float*)(ws + WS_FUSE + FU_RSS) + (l == 0 ? 0 : 2 * MTOT)}; run_gemm_res(L, Y, (const bf16_t*)(ws + WS_WOUT + (size_t)l * 8 * MiB), Mo, DM, DM, E, (float*)(ws + WS_PART), xbar); }
        SEAM(ph + 6);
        if (RUN(ph + 8)) { LAYER_VARS(); EpiFF1 E{(bf16_t*)(ws + WS_H), (const float*)(ws + WS_FUSE + FU_RSS) + (l == 0 ? 0 : 2 * MTOT), (const float*)(ws + WS_FUSE + FU_BIAS2) + (size_t)l * 5 * DFF}; run_gemm(L, XN, (const bf16_t*)(ws + WS_WFF1 + (size_t)l * 32 * MiB), Mo, DFF, DM, E); }
#ifdef PROBE_DUP_GI
        if (RUN(ph + 8)) { __syncthreads(); LAYER_VARS(); EpiFF1 E{(bf16_t*)(ws + WS_H), (const float*)(ws + WS_FUSE + FU_RSS) + (l == 0 ? 0 : 2 * MTOT), (const float*)(ws + WS_FUSE + FU_BIAS2) + (size_t)l * 5 * DFF}; run_gemm(L, XN, (const bf16_t*)(ws + WS_WFF1 + (size_t)l * 32 * MiB), Mo, DFF, DM, E); }
#endif
        SEAM(ph + 8);
        if (RUN(ph + 9)) { LAYER_VARS(); EpiRes E{X, X, X + (size_t)MLAT * DM, modl + 5 * DM, l == 0 ? XN : (bf16_t*)nullptr, a.in[6] + (size_t)DM, MOD + (size_t)5 * MODW + DM, (float*)(ws + WS_FUSE + FU_RSS) + MTOT}; run_gemm_res(L, (const bf16_t*)(ws + WS_H), (const bf16_t*)(ws + WS_WFF2 + (size_t)l * 32 * MiB), Mo, DM, DFF, E, (float*)(ws + WS_PART), xbar); }
        SEAM(ph + 9);
    }
#ifdef PROBE_SYNCS
    for (int i_ = 0; i_ < PROBE_SYNCS; ++i_) xcd_barrier(xbar);
#endif
    if (RUN(PH_FINAL)) { const int l_ = 0; FRESH(); phase_final(X, a.in[27], a.out, lane, wave); }
}

#ifndef MK_N_LAUNCHES
#define MK_N_LAUNCHES 1
#endif

extern "C" void kernel_launch(void* const* d_in, const int* in_sizes, int n_in, void* d_out, int out_size, void* d_ws, size_t ws_size, hipStream_t stream) {
    static int grid = 0;
    if (grid == 0) {
        if (n_in != 28 || ws_size < WS_END) { fprintf(stderr, "kernel_launch: unexpected n_in %d / ws %zu\n", n_in, ws_size); grid = -1; return; }
        int dev = 0, cus = 0, per_cu = 0;
        hipGetDevice(&dev); hipDeviceGetAttribute(&cus, hipDeviceAttributeMultiprocessorCount, dev);
        if (hipFuncSetAttribute((const void*)fwd_kernel, hipFuncAttributeMaxDynamicSharedMemorySize, LDS_BYTES) != hipSuccess) { fprintf(stderr, "kernel_launch: hipFuncSetAttribute failed\n"); grid = -1; return; }
        if (hipOccupancyMaxActiveBlocksPerMultiprocessor(&per_cu, (const void*)fwd_kernel, NTHR, LDS_BYTES) != hipSuccess || per_cu < 1) { fprintf(stderr, "kernel_launch: occupancy query gave %d\n", per_cu); per_cu = 1; }
        (void)hipGetLastError();
        grid = cus * (per_cu > 1 ? 1 : per_cu);
        if (grid <= 0) grid = 256;
    }
    if (grid < 0) return;
    if (hipMemsetAsync((char*)d_ws + WS_CTL, 0, 65536, stream) != hipSuccess) { fprintf(stderr, "kernel_launch: memset failed\n"); return; }
    Args a{};
    for (int i = 0; i < 28; ++i) a.in[i] = (const float*)d_in[i];
    a.out = (float*)d_out; a.ws = (unsigned char*)d_ws;
#if MK_N_LAUNCHES == 1
    a.ph_lo = 0; a.ph_hi = N_PHASES;
    void* args[] = {&a};
    hipError_t e = hipLaunchCooperativeKernel((const void*)fwd_kernel, dim3(grid), dim3(NTHR), args, LDS_BYTES, stream);
    if (e != hipSuccess) fprintf(stderr, "cooperative launch failed: %s (grid %d)\n", hipGetErrorString(e), grid);
#else
    for (int p = 0; p < N_PHASES; ++p) { a.ph_lo = p; a.ph_hi = p + 1; hipLaunchKernelGGL(fwd_kernel, dim3(grid), dim3(NTHR), LDS_BYTES, stream, a); }
#endif
}
```
